# Optimizing an MI355X kernel written in HIP

```python
import math
import jax, jax.numpy as jnp
from jax import lax
import numpy as np

D_MODEL = 2048
BATCH = 4
SEQ = 2048
DEPTH = 2
DEC_BATCH = 8
DEC_SEQ = 4096
PAST_LEN = 128

PLE_DIM = 256
EPS = 1e-6
CONV_CH = 512
CONV_WIDTH = 31
CONV_PAD = (CONV_WIDTH - 1) // 2
SSD_HEAD_DIM = 64
SSD_HEADS = 12
SSD_WIDTH = SSD_HEADS * SSD_HEAD_DIM
SSD_GROUPS = 2
SSD_HPG = SSD_HEADS // SSD_GROUPS
SSD_STATE = 128
SSD_CONV_WIDTH = 5
SSD_CONV_PAD = (SSD_CONV_WIDTH - 1) // 2
SSD_CHUNK = 128
SSD_XBC = SSD_WIDTH + 2 * SSD_GROUPS * SSD_STATE
ATT_HEADS = 6
ATT_HEAD_DIM = 64
ATT_WIDTH = ATT_HEADS * 2 * ATT_HEAD_DIM
Q_BLOCK = 128
REL_BUCKETS = 32
REL_MAX_DIST = 128
MIX_WIDTH = CONV_CH + SSD_WIDTH + ATT_WIDTH
D_FF = 4 * D_MODEL
IN_SIZES = (CONV_CH, CONV_CH, SSD_WIDTH, SSD_XBC, 2 * SSD_HEADS, ATT_WIDTH, ATT_WIDTH, ATT_WIDTH)
IN_COLS = sum(IN_SIZES)
IN_SPLITS = tuple(int(v) for v in np.cumsum(IN_SIZES)[:-1])

kernel_name = "hybrid_bidir_conv_ssd_diffattn_encoder"


def rmsnorm(x, g):
    xf = x.astype(jnp.float32)
    y = xf * lax.rsqrt(jnp.mean(xf * xf, axis=-1, keepdims=True) + EPS)
    return (y * g.astype(jnp.float32)).astype(x.dtype)


def layernorm(x, g, b):
    xf = x.astype(jnp.float32)
    mu = jnp.mean(xf, axis=-1, keepdims=True)
    var = jnp.mean(jnp.square(xf - mu), axis=-1, keepdims=True)
    y = (xf - mu) * lax.rsqrt(var + EPS)
    return (y * g.astype(jnp.float32) + b.astype(jnp.float32)).astype(x.dtype)


def depthwise_conv(x, w, pad):
    c = x.shape[-1]
    return lax.conv_general_dilated(
        x, w[:, None, :].astype(x.dtype), window_strides=(1,), padding=[(pad, pad)],
        dimension_numbers=("NWC", "WIO", "NWC"), feature_group_count=c)


def rel_bucket(rel):
    nb = REL_BUCKETS // 2
    max_exact = nb // 2
    ret = jnp.where(rel > 0, nb, 0)
    n = jnp.abs(rel)
    nf = jnp.maximum(n, 1).astype(jnp.float32)
    large = max_exact + (jnp.log(nf / max_exact) / math.log(REL_MAX_DIST / max_exact)
                         * (nb - max_exact)).astype(jnp.int32)
    large = jnp.minimum(large, nb - 1)
    return ret + jnp.where(n < max_exact, n, large)


def ssd_scan(xh, dt, A, B, C):
    b, l, G, R, P = xh.shape
    N = B.shape[-1]
    c = l // SSD_CHUNK
    Q = SSD_CHUNK
    dt_ = xh.dtype
    xh = xh.reshape(b, c, Q, G, R, P)
    dt = dt.reshape(b, c, Q, G, R)
    B = B.reshape(b, c, Q, G, N)
    C = C.reshape(b, c, Q, G, N)
    a_cs = jnp.cumsum((dt * A).astype(jnp.float32), axis=2)
    xdt = xh * dt[..., None]
    a_t = jnp.moveaxis(a_cs, 2, -1)
    seg = a_t[..., :, None] - a_t[..., None, :]
    tril = jnp.tril(jnp.ones((Q, Q), dtype=bool))
    L = jnp.exp(jnp.where(tril, seg, -jnp.inf)).astype(dt_)
    CB = jnp.einsum("bclgn,bcsgn->bcgls", C, B)
    y_diag = jnp.einsum("bcgls,bcgrls,bcsgrp->bclgrp", CB, L, xdt)
    decay_states = jnp.exp(a_cs[:, :, -1:] - a_cs).astype(dt_)
    states = jnp.einsum("bcsgn,bcsgr,bcsgrp->bcgrpn", B, decay_states, xdt)
    chunk_decay = jnp.exp(a_cs[:, :, -1]).astype(dt_)

    def step(carry, inp):
        st, dec = inp
        return carry * dec[..., None, None] + st, carry

    _, prev = lax.scan(step, jnp.zeros_like(states[:, 0]),
                       (jnp.moveaxis(states, 1, 0), jnp.moveaxis(chunk_decay, 1, 0)))
    prev = jnp.moveaxis(prev, 0, 1)
    y_off = jnp.einsum("bclgn,bcgrpn,bclgr->bclgrp", C, prev, jnp.exp(a_cs).astype(dt_))
    return (y_diag + y_off).reshape(b, l, G, R, P)


def conv_module(val, gate, conv_w, conv_b, norm_g, norm_b):
    u = val * jax.nn.sigmoid(gate)
    u = depthwise_conv(u, conv_w, CONV_PAD) + conv_b
    u = layernorm(u, norm_g, norm_b)
    return jax.nn.silu(u)


def ssd_mixer(z, xbc, dt_raw, conv_w, conv_b, dt_bias, a_log, d_skip, norm_g):
    b, l, _ = xbc.shape
    xbc = jax.nn.silu(depthwise_conv(xbc, conv_w, SSD_CONV_PAD) + conv_b)
    xs, Bm, Cm = jnp.split(xbc, [SSD_WIDTH, SSD_WIDTH + SSD_GROUPS * SSD_STATE], axis=-1)
    xh = xs.reshape(b, l, SSD_GROUPS, SSD_HPG, SSD_HEAD_DIM)
    Bm = Bm.reshape(b, l, SSD_GROUPS, SSD_STATE)
    Cm = Cm.reshape(b, l, SSD_GROUPS, SSD_STATE)
    dt = jax.nn.softplus(dt_raw.reshape(b, l, 2, SSD_GROUPS, SSD_HPG)
                         + dt_bias.reshape(2, SSD_GROUPS, SSD_HPG))
    A = -jnp.exp(a_log.reshape(2, SSD_GROUPS, SSD_HPG))
    y_f = ssd_scan(xh, dt[:, :, 0], A[0], Bm, Cm)
    fl = lambda t: jnp.flip(t, axis=1)
    y_b = fl(ssd_scan(fl(xh), fl(dt[:, :, 1]), A[1], fl(Bm), fl(Cm)))
    y = y_f + y_b + d_skip.reshape(SSD_GROUPS, SSD_HPG)[:, :, None] * xh
    y = y.reshape(b, l, SSD_WIDTH)
    return rmsnorm(y * jax.nn.silu(z), norm_g)


def diff_attention(q, k, v, lq1, lk1, lq2, lk2, subln_g, rel_bias, lam_init):
    b, s, _ = q.shape
    q = q.reshape(b, s, ATT_HEADS, 2, ATT_HEAD_DIM) * (ATT_HEAD_DIM ** -0.5)
    k = k.reshape(b, s, ATT_HEADS, 2, ATT_HEAD_DIM)
    v = v.reshape(b, s, ATT_HEADS, 2 * ATT_HEAD_DIM)
    f32 = jnp.float32
    lam = (jnp.exp(jnp.sum(lq1.astype(f32) * lk1.astype(f32)))
           - jnp.exp(jnp.sum(lq2.astype(f32) * lk2.astype(f32))) + lam_init)
    n_blk = s // Q_BLOCK
    q_blocks = jnp.moveaxis(q.reshape(b, n_blk, Q_BLOCK, ATT_HEADS, 2, ATT_HEAD_DIM), 1, 0)
    k_pos = jnp.arange(s, dtype=jnp.int32)

    def block(args):
        q_blk, start = args
        logits = jnp.einsum("bqhmd,bkhmd->bhmqk", q_blk, k).astype(f32)
        rel = k_pos[None, :] - (start + jnp.arange(Q_BLOCK, dtype=jnp.int32))[:, None]
        bias = jnp.transpose(rel_bias[rel_bucket(rel)], (2, 0, 1)).astype(f32)
        probs = jax.nn.softmax(logits + bias[None, :, None], axis=-1)
        a = (probs[:, :, 0] - lam * probs[:, :, 1]).astype(v.dtype)
        return jnp.einsum("bhqk,bkhe->bqhe", a, v)

    o = lax.map(block, (q_blocks, jnp.arange(n_blk, dtype=jnp.int32) * Q_BLOCK))
    o = jnp.moveaxis(o, 0, 1).reshape(b, s, ATT_HEADS, 2 * ATT_HEAD_DIM)
    o = rmsnorm(o, subln_g) * (1.0 - lam_init)
    return o.reshape(b, s, ATT_WIDTH)


def setup_inputs(seed: int = 0) -> dict:
    key = jax.random.key(seed)
    ks = jax.random.split(key, 32)
    nrm = lambda k, shape, scale: jax.random.normal(k, shape, jnp.float32) * scale
    gain = lambda k, shape: 1.0 + 0.02 * jax.random.normal(k, shape, jnp.float32)
    dt = jnp.exp(jax.random.uniform(ks[10], (DEPTH, 2, SSD_HEADS), jnp.float32,
                                    math.log(1e-3), math.log(1e-1)))
    dt_bias = dt + jnp.log(-jnp.expm1(-dt))
    a_log = jnp.log(jax.random.uniform(ks[11], (DEPTH, 2, SSD_HEADS), jnp.float32, 1.0, 16.0))
    return {
        "x_prompt": nrm(ks[0], (BATCH, SEQ, D_MODEL), 1.0),
        "x_sample": nrm(ks[1], (DEC_BATCH, DEC_SEQ, D_MODEL), 1.0),
        "p_prompt": nrm(ks[2], (DEPTH, BATCH, SEQ, PLE_DIM), 1.0),
        "p_sample": nrm(ks[3], (DEPTH, DEC_BATCH, DEC_SEQ, PLE_DIM), 1.0),
        "norm_mix_g": gain(ks[4], (DEPTH, D_MODEL)),
        "w_in": nrm(ks[5], (DEPTH, D_MODEL, IN_COLS), D_MODEL ** -0.5),
        "conv_w": nrm(ks[6], (DEPTH, CONV_WIDTH, CONV_CH), CONV_WIDTH ** -0.5),
        "conv_b": nrm(ks[7], (DEPTH, CONV_CH), 0.02),
        "conv_norm_g": gain(ks[8], (DEPTH, CONV_CH)),
        "conv_norm_b": nrm(ks[9], (DEPTH, CONV_CH), 0.02),
        "ssd_conv_w": nrm(ks[12], (DEPTH, SSD_CONV_WIDTH, SSD_XBC), SSD_CONV_WIDTH ** -0.5),
        "ssd_conv_b": nrm(ks[13], (DEPTH, SSD_XBC), 0.02),
        "ssd_dt_bias": dt_bias,
        "ssd_a_log": a_log,
        "ssd_d": gain(ks[14], (DEPTH, SSD_HEADS)),
        "ssd_norm_g": gain(ks[15], (DEPTH, SSD_WIDTH)),
        "lambda_q1": nrm(ks[16], (DEPTH, ATT_HEAD_DIM), 0.1),
        "lambda_k1": nrm(ks[17], (DEPTH, ATT_HEAD_DIM), 0.1),
        "lambda_q2": nrm(ks[18], (DEPTH, ATT_HEAD_DIM), 0.1),
        "lambda_k2": nrm(ks[19], (DEPTH, ATT_HEAD_DIM), 0.1),
        "attn_subln_g": gain(ks[20], (DEPTH, 2 * ATT_HEAD_DIM)),
        "rel_bias": nrm(ks[21], (REL_BUCKETS, ATT_HEADS), 0.5),
        "w_out": nrm(ks[22], (DEPTH, MIX_WIDTH, D_MODEL), MIX_WIDTH ** -0.5),
        "norm_mlp_g": gain(ks[23], (DEPTH, D_MODEL)),
        "w_up": nrm(ks[24], (DEPTH, D_MODEL, D_FF), D_MODEL ** -0.5),
        "w_down": nrm(ks[25], (DEPTH, D_FF, D_MODEL), D_FF ** -0.5),
        "norm_ple_g": gain(ks[26], (DEPTH, D_MODEL)),
        "w_ple": nrm(ks[27], (DEPTH, PLE_DIM, D_MODEL), PLE_DIM ** -0.5),
        "w_ple_gate": nrm(ks[28], (DEPTH, D_MODEL, D_MODEL), D_MODEL ** -0.5),
        "final_norm_g": gain(ks[29], (D_MODEL,)),
    }


def reference(x_prompt, x_sample, p_prompt, p_sample, norm_mix_g, w_in, conv_w, conv_b,
              conv_norm_g, conv_norm_b, ssd_conv_w, ssd_conv_b, ssd_dt_bias, ssd_a_log, ssd_d,
              ssd_norm_g, lambda_q1, lambda_k1, lambda_q2, lambda_k2, attn_subln_g, rel_bias,
              w_out, norm_mlp_g, w_up, w_down, norm_ple_g, w_ple, w_ple_gate, final_norm_g):

    def run(x, p):
        h = x
        for i in range(DEPTH):
            lam_init = 0.8 - 0.6 * math.exp(-0.3 * i)
            u = rmsnorm(h, norm_mix_g[i])
            proj = jnp.einsum("bsd,dc->bsc", u, w_in[i])
            c_val, c_gate, s_z, s_xbc, s_dt, a_q, a_k, a_v = jnp.split(proj, IN_SPLITS, axis=-1)
            y_conv = conv_module(c_val, c_gate, conv_w[i], conv_b[i], conv_norm_g[i], conv_norm_b[i])
            y_ssd = ssd_mixer(s_z, s_xbc, s_dt, ssd_conv_w[i], ssd_conv_b[i], ssd_dt_bias[i],
                              ssd_a_log[i], ssd_d[i], ssd_norm_g[i])
            y_att = diff_attention(a_q, a_k, a_v, lambda_q1[i], lambda_k1[i], lambda_q2[i],
                                   lambda_k2[i], attn_subln_g[i], rel_bias, lam_init)
            mix = jnp.concatenate([y_conv, y_ssd, y_att], axis=-1)
            h = h + jnp.einsum("bsc,cd->bsd", mix, w_out[i])
            u = rmsnorm(h, norm_mlp_g[i])
            hid = jnp.square(jax.nn.relu(jnp.einsum("bsd,df->bsf", u, w_up[i])))
            h = h + jnp.einsum("bsf,fd->bsd", hid, w_down[i])
            gate = jax.nn.sigmoid(jnp.einsum("bsd,de->bse", rmsnorm(h, norm_ple_g[i]), w_ple_gate[i]))
            h = h + jnp.einsum("bsk,kd->bsd", p[i], w_ple[i]) * gate
        return rmsnorm(h, final_norm_g)

    y_prompt = run(x_prompt, p_prompt)
    y_sample = run(x_sample, p_sample)
    return (y_prompt, y_sample)
```

```cpp
#include <hip/hip_runtime.h>
#include <hip/hip_cooperative_groups.h>
#include <cstdio>
#include <cstdint>
#include <cmath>
namespace cg = cooperative_groups;

#ifndef MK_MULTI
#define MK_MULTI 0
#endif

#ifndef PROBE_SUB
#define PROBE_SUB -1
#endif
#ifndef PHMASK
#define PHMASK 0xFFFFu
#endif
#define PHON(n) (((PHMASK) >> (n)) & 1u)
#define LAS __attribute__((address_space(3)))
typedef unsigned short bf16_t;
typedef short bf16x8 __attribute__((ext_vector_type(8)));
typedef short s16x4 __attribute__((ext_vector_type(4)));
typedef float f32x4 __attribute__((ext_vector_type(4)));
typedef float f32x2 __attribute__((ext_vector_type(2)));
typedef float f32x16 __attribute__((ext_vector_type(16)));
typedef unsigned u32x4 __attribute__((ext_vector_type(4)));
typedef unsigned u32x2 __attribute__((ext_vector_type(2)));
typedef __bf16 bf16x2_t __attribute__((ext_vector_type(2)));

constexpr int DM = 2048, TP = 4 * 2048, TS = 8 * 4096, T = TP + TS;
constexpr int IN_COLS = 5400, PROJ_PITCH = 5632, DFF = 8192, PLE = 256;
constexpr int ZOFF = 1024, XBCOFF = 1792, QOFF = 3072, KOFF = 3840, VOFF = 4608, DTOFF = 5376;
constexpr int XBC_W = 1280, SSD_W = 768;
constexpr float EPS = 1e-6f, LOG2E = 1.4426950408889634f;
constexpr size_t MiB = 1u << 20;
constexpr size_t WS_CTL = 0, WS_DT = 1 * MiB, WS_WIN = 6 * MiB, WS_WOUT = 28 * MiB, WS_WUP = 36 * MiB, WS_WDN = 68 * MiB, WS_WG = 100 * MiB, WS_WPLE = 108 * MiB;
constexpr size_t WS_U = 110 * MiB, WS_YF = 110 * MiB, WS_YB = 170 * MiB;
constexpr size_t WS_X = 270 * MiB, WS_PROJ = 270 * MiB, WS_MIX = 710 * MiB, WS_HID = 270 * MiB, WS_PE = 270 * MiB;
constexpr size_t WS_E = 910 * MiB, WS_XBC = 910 * MiB, WS_PB = 910 * MiB, WS_RSS = 1010 * MiB, WS_END = 1014 * MiB;
typedef unsigned long long u64_t;
constexpr float RSS_SCALE = 1048576.f, RSS_INV = 1.f / (1048576.f * 2048.f);
constexpr size_t WS_HB = 110 * MiB, WS_HB2 = 710 * MiB;
constexpr int LDS_BYTES = 147456;
constexpr int NSUB = 10, NPH_LAYER = NSUB + (PROBE_SUB >= 0 ? 1 : 0), NPHASES = 2 * NPH_LAYER + 1;

__device__ __forceinline__ float bf2f(unsigned v) { return __uint_as_float(v << 16); }
__device__ __forceinline__ unsigned cvtpk(float lo, float hi) { f32x2 v = {lo, hi}; bf16x2_t b = __builtin_convertvector(v, bf16x2_t); return __builtin_bit_cast(unsigned, b); }
__device__ __forceinline__ bf16_t f2bf(float f) { return (bf16_t)(cvtpk(f, 0.f) & 0xffffu); }
__device__ __forceinline__ void unpack8(const u32x4 w, float (&f)[8]) {
#pragma unroll
    for (int k = 0; k < 4; ++k) { f[2 * k] = __uint_as_float(w[k] << 16); f[2 * k + 1] = __uint_as_float(w[k] & 0xffff0000u); }
}
__device__ __forceinline__ float wave_sum(float v) {
#pragma unroll
    for (int o = 1; o < 64; o <<= 1) v += __shfl_xor(v, o);
    return v;
}
__device__ __forceinline__ int opaque_tid() { int t = threadIdx.x; asm volatile("" : "+v"(t)); return t; }
__device__ __forceinline__ float sigmoidf_(float x) { return 1.f / (1.f + __expf(-x)); }
__device__ __forceinline__ float siluf_(float x) { return x / (1.f + __expf(-x)); }

namespace pg8 {
constexpr int BM = 256, BK = 64, HALF = 128, HTB = HALF * BK * 2, STAGE_BYTES = 8 * HTB, NXCD = 8, WGM = 8;
__host__ __device__ __forceinline__ int lds_byte(int r, int c) { const int st = (r >> 4) * 2 + (c >> 5), rr = r & 15, cc = c & 31, ob = rr * 64 + cc * 2; return st * 1024 + (ob ^ (((ob >> 9) & 1) << 5)); }
__host__ __device__ __forceinline__ void stage_rc(int b, int& R, int& C) { const int st = b / 1024, sb = b % 1024, swz = sb ^ (((sb >> 9) & 1) << 5); R = (st >> 1) * 16 + swz / 64; C = (st & 1) * 32 + (swz % 64) / 2; }
__host__ __device__ __forceinline__ int perm32(int rho) { const int n = rho >> 4, i = rho & 15; return 8 * (i >> 2) + 4 * n + (i & 3); }
struct Unit { int pm, pn; };
struct Gemm { const bf16_t* A; const bf16_t* Bt; int M, N, K; };
struct StaticOrder {
    int nM, nN, nwg, G, c;
    __host__ __device__ void init(int M, int N, int G_, int c_) { nM = M / BM; nN = N / BM; nwg = nM * nN; G = G_; c = c_; }
    __host__ __device__ bool next(int i, Unit& u) const {
        const long L = (long)i * G + c; if (L >= nwg) return false;
        int wgid = (int)L; { const int q = nwg / NXCD, r = nwg % NXCD, xcd = wgid % NXCD, off = wgid / NXCD; wgid = (xcd < r ? xcd * (q + 1) : r * (q + 1) + (xcd - r) * q) + off; }
        const int nig = WGM * nN, gid = wgid / nig, fm = gid * WGM, gsz = (nM - fm) < WGM ? (nM - fm) : WGM;
        u.pm = fm + ((wgid % nig) % gsz); u.pn = (wgid % nig) / gsz; return true;
    }
};
template <class Epi>
__device__ __forceinline__ void gemm_phase(LAS unsigned char* lds, const Gemm g, const StaticOrder& S, const Epi& E) {
    const int tid = opaque_tid(), wid = __builtin_amdgcn_readfirstlane(tid >> 6), lane = tid & 63, wr = wid >> 2, wc = wid & 3, fr = lane & 15, fq = lane >> 4;
    const int K = g.K, nt = K / BK;
    unsigned voffA[2], voffB[2];
#pragma unroll
    for (int i = 0; i < 2; ++i) { int R, C; stage_rc(tid * 16 + i * 8192, R, C); const int Rb = E.perm ? ((R & ~31) + perm32(R & 31)) : R;
        voffA[i] = (unsigned)(R * K + C) * 2u; voffB[i] = (unsigned)(Rb * K + C) * 2u; }
    const size_t kstep = (size_t)(BK * 2);
    const size_t hstep = (size_t)HALF * K * 2;
    const size_t tstep = 2 * hstep;
    const unsigned ldsw = (unsigned)wid * 1024u;
    const int aoff = lds_byte(wr * 64 + fr, fq * 8), boff = lds_byte(wc * 32 + fr, fq * 8);
#define PG8_SA(b, h) (((b) * 2 + (h)) * HTB)
#define PG8_SB(b, h) ((4 + (b) * 2 + (h)) * HTB)
#define PG8_STAGE(bufoff, gbase, voff) do { _Pragma("unroll") for (int _i = 0; _i < 2; ++_i) \
        __builtin_amdgcn_global_load_lds((const unsigned*)((const char*)(gbase) + (voff)[_i]), (LAS unsigned*)(lds + (bufoff) + ldsw + _i * 8192), 16, 0, 0); } while (0)
#define PG8_LDA(dst, b, h) do { _Pragma("unroll") for (int m = 0; m < 4; ++m) _Pragma("unroll") for (int k = 0; k < 2; ++k) dst[m][k] = *(const LAS bf16x8*)(lds + PG8_SA(b, h) + aoff + m * 2048 + k * 1024); } while (0)
#define PG8_LDB(dst, b, h) do { _Pragma("unroll") for (int n = 0; n < 2; ++n) _Pragma("unroll") for (int k = 0; k < 2; ++k) dst[n][k] = *(const LAS bf16x8*)(lds + PG8_SB(b, h) + boff + n * 2048 + k * 1024); } while (0)
#define PG8_MMA(ai, bj, At, Bt) do { __builtin_amdgcn_s_setprio(1); _Pragma("unroll") for (int m = 0; m < 4; ++m) _Pragma("unroll") for (int n = 0; n < 2; ++n) _Pragma("unroll") for (int k = 0; k < 2; ++k) \
        acc[ai][bj][m][n] = __builtin_amdgcn_mfma_f32_16x16x32_bf16(Bt[n][k], At[m][k], acc[ai][bj][m][n], 0, 0, 0); __builtin_amdgcn_s_setprio(0); } while (0)
#define PG8_WAIT_V(n) asm volatile("s_waitcnt vmcnt(" #n ")" ::: "memory")
#define PG8_WAIT_L(n) asm volatile("s_waitcnt lgkmcnt(" #n ")" ::: "memory")
#define PG8_BAR __builtin_amdgcn_s_barrier()
#define PG8_SCHED __builtin_amdgcn_sched_barrier(0)
    Unit cur, nxt; int ui = 0;
    if (!S.next(0, cur)) return;
    f32x4 acc[2][2][4][2];
#pragma unroll
    for (int a = 0; a < 2; ++a)
#pragma unroll
        for (int b = 0; b < 2; ++b)
#pragma unroll
            for (int m = 0; m < 4; ++m)
#pragma unroll
                for (int n = 0; n < 2; ++n) acc[a][b][m][n] = (f32x4){0.f, 0.f, 0.f, 0.f};
    bf16x8 At[4][2], B0[2][2], B1[2][2];
    const char* cA = (const char*)g.A + (size_t)cur.pm * tstep; const char* cB = (const char*)g.Bt + (size_t)cur.pn * tstep;
    PG8_STAGE(PG8_SB(0, 0), cB, voffB); PG8_STAGE(PG8_SB(0, 1), cB + hstep, voffB); PG8_STAGE(PG8_SA(0, 0), cA, voffA); PG8_STAGE(PG8_SA(0, 1), cA + hstep, voffA);
    if (wr == 1) PG8_BAR;
    PG8_WAIT_V(2); PG8_BAR;
    PG8_STAGE(PG8_SB(1, 0), cB + kstep, voffB); PG8_STAGE(PG8_SA(1, 0), cA + kstep, voffA); PG8_STAGE(PG8_SB(1, 1), cB + hstep + kstep, voffB);
    PG8_WAIT_V(6); PG8_BAR;
    for (;;) {
        const bool has_next = S.next(ui + 1, nxt);
        const char* nA = has_next ? (const char*)g.A + (size_t)nxt.pm * tstep : cA; const char* nB = has_next ? (const char*)g.Bt + (size_t)nxt.pn * tstep : cB;
        for (int t = 0; t < nt; t += 2) {
            const bool last = (t == nt - 2);
            const char* a1 = cA + (size_t)(t + 1) * kstep;
            const char* a2 = last ? nA : cA + (size_t)(t + 2) * kstep; const char* b2 = last ? nB : cB + (size_t)(t + 2) * kstep;
            const char* a3 = a2 + kstep; const char* b3 = b2 + kstep;
            PG8_LDB(B0, 0, 0); PG8_LDB(B1, 0, 1); PG8_SCHED; PG8_LDA(At, 0, 0); PG8_STAGE(PG8_SA(1, 1), a1 + hstep, voffA);
            PG8_WAIT_V(8); PG8_WAIT_L(0); PG8_BAR; PG8_MMA(0, 0, At, B0); PG8_MMA(0, 1, At, B1); PG8_BAR; PG8_SCHED;
            PG8_LDA(At, 0, 1); PG8_STAGE(PG8_SB(0, 0), b2, voffB); PG8_STAGE(PG8_SB(0, 1), b2 + hstep, voffB); PG8_STAGE(PG8_SA(0, 0), a2, voffA);
            PG8_WAIT_V(8); PG8_WAIT_L(0); PG8_BAR; PG8_MMA(1, 0, At, B0); PG8_MMA(1, 1, At, B1); PG8_BAR; PG8_SCHED;
            PG8_LDB(B0, 1, 0); PG8_LDB(B1, 1, 1); PG8_SCHED; PG8_LDA(At, 1, 0); PG8_STAGE(PG8_SA(0, 1), a2 + hstep, voffA);
            PG8_WAIT_V(8); PG8_WAIT_L(0); PG8_BAR; PG8_MMA(0, 0, At, B0); PG8_MMA(0, 1, At, B1); PG8_BAR; PG8_SCHED;
            PG8_LDA(At, 1, 1); PG8_STAGE(PG8_SB(1, 0), b3, voffB); PG8_STAGE(PG8_SB(1, 1), b3 + hstep, voffB); PG8_STAGE(PG8_SA(1, 0), a3, voffA);
            PG8_WAIT_V(8); PG8_WAIT_L(0); PG8_BAR; PG8_MMA(1, 0, At, B0); PG8_MMA(1, 1, At, B1); PG8_BAR; PG8_SCHED;
        }
        if (wr == 0) PG8_BAR;
        E(acc, cur, wr, wc, fr, fq);
        if (!has_next) break;
#pragma unroll
        for (int a = 0; a < 2; ++a)
#pragma unroll
            for (int b = 0; b < 2; ++b)
#pragma unroll
                for (int m = 0; m < 4; ++m)
#pragma unroll
                    for (int n = 0; n < 2; ++n) acc[a][b][m][n] = (f32x4){0.f, 0.f, 0.f, 0.f};
        cur = nxt; cA = nA; cB = nB; ++ui;
        if (wr == 1) PG8_BAR;
    }
    PG8_WAIT_V(0);
    PG8_BAR;
#undef PG8_SA
#undef PG8_SB
#undef PG8_STAGE
#undef PG8_LDA
#undef PG8_LDB
#undef PG8_MMA
#undef PG8_WAIT_V
#undef PG8_WAIT_L
#undef PG8_BAR
#undef PG8_SCHED
}

typedef const f32x4 (&AccRef)[2][2][4][2];
struct EpiAny { int kind; bool perm; bf16_t* O; int ldc; const bf16_t* Hs; float* dt; const bf16_t* PE; bf16_t* HB; const u64_t* rin; u64_t* rout;
    __device__ __forceinline__ void operator()(AccRef acc, const Unit& u, int wr, int wc, int fr, int fq) const {
        const int row0 = u.pm * BM + wr * 64 + fr, col0 = u.pn * BM + wc * 32 + 8 * fq;
        if (kind == 1 || kind == 4) {
#pragma unroll
            for (int ai = 0; ai < 2; ++ai) {
                u32x4 hw[4][2], pw[4][2]; float rsv[4];
#pragma unroll
                for (int m = 0; m < 4; ++m) { const int row = row0 + ai * HALF + m * 16; const size_t ro = (size_t)row * DM + col0;
                    rsv[m] = 1.f; if (kind == 4) rsv[m] = (float)rin[row];
#pragma unroll
                    for (int bj = 0; bj < 2; ++bj) { hw[m][bj] = *(const u32x4*)(Hs + ro + bj * HALF); if (kind == 4) pw[m][bj] = *(const u32x4*)(PE + ro + bj * HALF); else pw[m][bj] = (u32x4){0u, 0u, 0u, 0u}; } }
#pragma unroll
                for (int m = 0; m < 4; ++m) { const int row = row0 + ai * HALF + m * 16; const size_t ro = (size_t)row * DM + col0; float ssq = 0.f;
                    float rs = 1.f; if (kind == 4) rs = rsqrtf(rsv[m] * RSS_INV + EPS);
#pragma unroll
                    for (int bj = 0; bj < 2; ++bj) { f32x4 v0 = acc[ai][bj][m][0], v1 = acc[ai][bj][m][1];
                        float hf[8]; unpack8(hw[m][bj], hf);
                        if (kind == 4) { float pe[8]; unpack8(pw[m][bj], pe);
#pragma unroll
                            for (int j = 0; j < 4; ++j) { v0[j] = pe[j] * sigmoidf_(v0[j] * rs); v1[j] = pe[4 + j] * sigmoidf_(v1[j] * rs); } }
#pragma unroll
                        for (int j = 0; j < 4; ++j) { v0[j] += hf[j]; v1[j] += hf[4 + j]; }
                        ssq += (v0.x * v0.x + v0.y * v0.y) + (v0.z * v0.z + v0.w * v0.w) + (v1.x * v1.x + v1.y * v1.y) + (v1.z * v1.z + v1.w * v1.w);
                        u32x4 w; w.x = cvtpk(v0[0], v0[1]); w.y = cvtpk(v0[2], v0[3]); w.z = cvtpk(v1[0], v1[1]); w.w = cvtpk(v1[2], v1[3]);
                        *(u32x4*)(HB + ro + bj * HALF) = w; }
                    ssq += __shfl_xor(ssq, 16); ssq += __shfl_xor(ssq, 32);
                    if (fq == 0) atomicAdd(rout + row, (u64_t)(ssq * RSS_SCALE)); }
                asm volatile("" ::: "memory"); }
        } else {
            const bool sq = (kind == 2), nrm = (kind != 3);
#pragma unroll
            for (int ai = 0; ai < 2; ++ai)
#pragma unroll
                for (int m = 0; m < 4; ++m) { const int row = row0 + ai * HALF + m * 16; bf16_t* rowp = O + (size_t)row * ldc + col0;
                    float rs = 1.f; if (nrm) rs = rsqrtf((float)rin[row] * RSS_INV + EPS);
#pragma unroll
                    for (int bj = 0; bj < 2; ++bj) { f32x4 v0 = acc[ai][bj][m][0] * rs, v1 = acc[ai][bj][m][1] * rs;
                        if (sq) {
#pragma unroll
                            for (int j = 0; j < 4; ++j) { const float a = fmaxf(v0[j], 0.f), b = fmaxf(v1[j], 0.f); v0[j] = a * a; v1[j] = b * b; } }
                        u32x4 w; w.x = cvtpk(v0[0], v0[1]); w.y = cvtpk(v0[2], v0[3]); w.z = cvtpk(v1[0], v1[1]); w.w = cvtpk(v1[2], v1[3]);
                        *(u32x4*)(rowp + bj * HALF) = w; }
                    if (kind == 0 && u.pn == DTOFF / BM && wc == 0) { float* dp = dt + (size_t)row * 32 + 8 * fq; *(f32x4*)dp = acc[ai][0][m][0] * rs; *(f32x4*)(dp + 4) = acc[ai][0][m][1] * rs; } }
        }
    }
};
}

struct Params { const float* in[30]; float* out; unsigned char* ws; int ph_lo, ph_hi; };
typedef const __attribute__((address_space(4))) Params CP;
enum { I_XP = 0, I_XS, I_PP, I_PS, I_NMIXG, I_WIN, I_CONVW, I_CONVB, I_CNG, I_CNB, I_SCW, I_SCB, I_DTB, I_ALOG, I_SSDD, I_SSDNG, I_LQ1, I_LK1, I_LQ2, I_LK2, I_SUBLN, I_RELB, I_WOUT, I_NMLPG, I_WUP, I_WDN, I_NPLEG, I_WPLE, I_WG, I_FNG };

__device__ __forceinline__ void seq_of(int sq, int& start, int& len) { if (sq < 4) { start = sq * 2048; len = 2048; } else { start = TP + (sq - 4) * 4096; len = 4096; } }
__device__ __forceinline__ void seq_bounds_of_tok(int t, int& start, int& end) { if (t < TP) { start = t & ~2047; end = start + 2048; } else { start = TP + ((t - TP) & ~4095); end = start + 4096; } }

__device__ __forceinline__ int map_in_col(int nd) {
    if (nd < QOFF) return nd;
    if (nd < DTOFF) return nd + 24;
    if (nd < DTOFF + 24) return nd - DTOFF + QOFF;
    return -1;
}
template <bool MAPIN>
__device__ __forceinline__ void transpose_item(const float* W, const float* gk, int K, int Nsrc, int nblk, bf16_t* WT, LAS float* scr, int item, int lane) {
    const int kb = item / nblk, nb = item % nblk, k0 = 64 * kb, n0 = 32 * nb;
    const int nd = n0 + (lane & 31); const int ns = MAPIN ? map_in_col(nd) : nd;
#pragma unroll 8
    for (int i = 0; i < 32; ++i) { const int kk = 2 * i + (lane >> 5); const float gg = gk ? gk[k0 + kk] : 1.f; scr[kk * 33 + (lane & 31)] = (ns >= 0) ? W[(size_t)(k0 + kk) * Nsrc + ns] * gg : 0.f; }
    asm volatile("s_waitcnt lgkmcnt(0)" ::: "memory");
    const int c = lane & 7;
#pragma unroll
    for (int j = 0; j < 4; ++j) { const int n = (lane >> 3) + 8 * j; const LAS float* s = scr + (8 * c) * 33 + n;
        u32x4 o; o.x = cvtpk(s[0 * 33], s[1 * 33]); o.y = cvtpk(s[2 * 33], s[3 * 33]); o.z = cvtpk(s[4 * 33], s[5 * 33]); o.w = cvtpk(s[6 * 33], s[7 * 33]);
        *(u32x4*)(WT + (size_t)(n0 + n) * K + k0 + 8 * c) = o; }
    asm volatile("s_waitcnt lgkmcnt(0)" ::: "memory");
}
__device__ __forceinline__ void prep_row(const float* src, bf16_t* hb, u64_t* rss, int lane) {
    const f32x4* xr = (const f32x4*)src + lane; f32x4 v[8]; float s = 0.f;
#pragma unroll
    for (int j = 0; j < 8; ++j) { v[j] = xr[64 * j]; s += (v[j].x * v[j].x + v[j].y * v[j].y) + (v[j].z * v[j].z + v[j].w * v[j].w); }
    s = wave_sum(s);
#pragma unroll
    for (int j = 0; j < 8; ++j) { u32x2 w; w.x = cvtpk(v[j].x, v[j].y); w.y = cvtpk(v[j].z, v[j].w); ((u32x2*)hb + lane)[64 * j] = w; }
    if (lane == 0) *rss = (u64_t)(s * RSS_SCALE);
}
__device__ __forceinline__ void final_row(const bf16_t* h, float* out, const float* g, u64_t ss, int lane) {
    const float rstd = rsqrtf((float)ss * RSS_INV + EPS);
    const u32x2* hr = (const u32x2*)h + lane; f32x4* orow = (f32x4*)out + lane; const f32x4* gr = (const f32x4*)g + lane;
#pragma unroll
    for (int j = 0; j < 8; ++j) { const u32x2 w = hr[64 * j]; const f32x4 gg = gr[64 * j];
        f32x4 v; v.x = __uint_as_float(w.x << 16); v.y = __uint_as_float(w.x & 0xffff0000u); v.z = __uint_as_float(w.y << 16); v.w = __uint_as_float(w.y & 0xffff0000u);
        orow[64 * j] = v * rstd * gg; }
}

__device__ __forceinline__ void conv_module_item(CP& P, int L, int item, LAS unsigned char* lds) {
    const int tid = opaque_tid(), lane = tid & 63, wid = tid >> 6;
    const bf16_t* proj = (const bf16_t*)(P.ws + WS_PROJ); bf16_t* mix = (bf16_t*)(P.ws + WS_MIX);
    const int t0 = item * 32; int s0, s1; seq_bounds_of_tok(t0, s0, s1);
    LAS float* U = (LAS float*)lds;
#pragma unroll
    for (int i = 0; i < 8; ++i) { const int id = tid + 512 * i, rr = id >> 6, c8 = (id & 63) * 8; const int t = t0 - 15 + rr;
        if (rr < 62) { f32x4 u0 = {0.f, 0.f, 0.f, 0.f}, u1 = {0.f, 0.f, 0.f, 0.f};
            if (t >= s0 && t < s1) { const u32x4 vv = *(const u32x4*)(proj + (size_t)t * PROJ_PITCH + c8), gv = *(const u32x4*)(proj + (size_t)t * PROJ_PITCH + 512 + c8);
                float v[8], g[8]; unpack8(vv, v); unpack8(gv, g);
#pragma unroll
                for (int j = 0; j < 4; ++j) { u0[j] = v[j] * sigmoidf_(g[j]); u1[j] = v[4 + j] * sigmoidf_(g[4 + j]); } }
            *(LAS f32x4*)(U + rr * 512 + c8) = u0; *(LAS f32x4*)(U + rr * 512 + c8 + 4) = u1; } }
    float w[31];
#pragma unroll
    for (int j = 0; j < 31; ++j) w[j] = P.in[I_CONVW][(size_t)L * 31 * 512 + j * 512 + tid];
    const float cb = P.in[I_CONVB][L * 512 + tid];
    __syncthreads();
    float o[32];
    {   float u[62];
#pragma unroll
        for (int rr = 0; rr < 62; ++rr) u[rr] = U[rr * 512 + tid];
#pragma unroll
        for (int tt = 0; tt < 32; ++tt) { float a = cb;
#pragma unroll
            for (int j = 0; j < 31; ++j) a += u[tt + j] * w[j];
            o[tt] = a; } }
    __syncthreads();
#pragma unroll
    for (int tt = 0; tt < 32; ++tt) U[tt * 512 + tid] = o[tt];
    __syncthreads();
    const f32x4 g0 = *((const f32x4*)(P.in[I_CNG] + L * 512) + 2 * lane), g1 = *((const f32x4*)(P.in[I_CNG] + L * 512) + 2 * lane + 1);
    const f32x4 b0 = *((const f32x4*)(P.in[I_CNB] + L * 512) + 2 * lane), b1 = *((const f32x4*)(P.in[I_CNB] + L * 512) + 2 * lane + 1);
#pragma unroll
    for (int k = 0; k < 4; ++k) { const int tt = wid * 4 + k;
        const f32x4 x0 = *((const LAS f32x4*)(U + tt * 512) + 2 * lane), x1 = *((const LAS f32x4*)(U + tt * 512) + 2 * lane + 1);
        const float mu = wave_sum((x0.x + x0.y) + (x0.z + x0.w) + (x1.x + x1.y) + (x1.z + x1.w)) * (1.f / 512.f);
        const f32x4 d0 = x0 - mu, d1 = x1 - mu;
        const float var = wave_sum((d0.x * d0.x + d0.y * d0.y) + (d0.z * d0.z + d0.w * d0.w) + (d1.x * d1.x + d1.y * d1.y) + (d1.z * d1.z + d1.w * d1.w)) * (1.f / 512.f);
        const float rstd = rsqrtf(var + EPS);
        f32x4 y0 = d0 * rstd * g0 + b0, y1 = d1 * rstd * g1 + b1;
#pragma unroll
        for (int j = 0; j < 4; ++j) { y0[j] = siluf_(y0[j]); y1[j] = siluf_(y1[j]); }
        u32x4 wv; wv.x = cvtpk(y0[0], y0[1]); wv.y = cvtpk(y0[2], y0[3]); wv.z = cvtpk(y1[0], y1[1]); wv.w = cvtpk(y1[2], y1[3]);
        *(u32x4*)(mix + (size_t)(t0 + tt) * DM + 8 * lane) = wv; }
    __syncthreads();
}
__device__ __forceinline__ void xbc_conv_item(CP& P, int L, int item) {
    const int tid = opaque_tid(); const int cg = tid % 160, rs = tid / 160; const int seg = item * 3 + rs;
    if (rs >= 3 || seg >= T / 32) return;
    const bf16_t* proj = (const bf16_t*)(P.ws + WS_PROJ); bf16_t* xbc = (bf16_t*)(P.ws + WS_XBC);
    const int c8 = cg * 8, r0 = seg * 32; int s0, s1; seq_bounds_of_tok(r0, s0, s1);
    const float* cw = P.in[I_SCW] + (size_t)L * 5 * XBC_W + c8; const float* cbp = P.in[I_SCB] + L * XBC_W + c8;
    float w[5][8], bs[8];
#pragma unroll
    for (int j = 0; j < 5; ++j) { const f32x4 a = *(const f32x4*)(cw + j * XBC_W), b = *(const f32x4*)(cw + j * XBC_W + 4); w[j][0] = a.x; w[j][1] = a.y; w[j][2] = a.z; w[j][3] = a.w; w[j][4] = b.x; w[j][5] = b.y; w[j][6] = b.z; w[j][7] = b.w; }
    { const f32x4 a = *(const f32x4*)cbp, b = *(const f32x4*)(cbp + 4); bs[0] = a.x; bs[1] = a.y; bs[2] = a.z; bs[3] = a.w; bs[4] = b.x; bs[5] = b.y; bs[6] = b.z; bs[7] = b.w; }
    const bf16_t* src = proj + XBCOFF + c8;
    u32x4 win[5];
#pragma unroll
    for (int j = 0; j < 4; ++j) { const int t = r0 - 2 + j; win[j + 1] = (t >= s0 && t < s1) ? *(const u32x4*)(src + (size_t)t * PROJ_PITCH) : (u32x4){0u, 0u, 0u, 0u}; }
#pragma unroll 4
    for (int r = 0; r < 32; ++r) {
#pragma unroll
        for (int j = 0; j < 4; ++j) win[j] = win[j + 1];
        { const int t = r0 + r + 2; win[4] = (t >= s0 && t < s1) ? *(const u32x4*)(src + (size_t)t * PROJ_PITCH) : (u32x4){0u, 0u, 0u, 0u}; }
        float a[8];
#pragma unroll
        for (int k = 0; k < 8; ++k) a[k] = bs[k];
#pragma unroll
        for (int j = 0; j < 5; ++j) { float x[8]; unpack8(win[j], x);
#pragma unroll
            for (int k = 0; k < 8; ++k) a[k] += x[k] * w[j][k]; }
#pragma unroll
        for (int k = 0; k < 8; ++k) a[k] = siluf_(a[k]);
        u32x4 o; o.x = cvtpk(a[0], a[1]); o.y = cvtpk(a[2], a[3]); o.z = cvtpk(a[4], a[5]); o.w = cvtpk(a[6], a[7]);
        *(u32x4*)(xbc + (size_t)(r0 + r) * XBC_W + c8) = o;
    }
}

#define MFMA32(a, b, c) __builtin_amdgcn_mfma_f32_32x32x16_bf16((a), (b), (c), 0, 0, 0)
__device__ __forceinline__ int crow(int r, int hi) { return (r & 3) + 8 * (r >> 2) + 4 * hi; }
__device__ __forceinline__ bf16x8 pack_step(const f32x16& x, int s) {
    u32x4 p; p.x = cvtpk(x[8 * s], x[8 * s + 1]); p.y = cvtpk(x[8 * s + 2], x[8 * s + 3]); p.z = cvtpk(x[8 * s + 4], x[8 * s + 5]); p.w = cvtpk(x[8 * s + 6], x[8 * s + 7]);
    return __builtin_bit_cast(bf16x8, p);
}

typedef short v4i16s_t __attribute__((ext_vector_type(4)));
constexpr int SP = 272, SXP = 144;
constexpr int S_CM = 0, S_BM = 128 * SP, S_BD = 2 * 128 * SP, S_XD = 3 * 128 * SP, S_PV = S_XD + 128 * SXP, S_AS = S_PV + 64 * SP, S_DTV = S_AS + 132 * 4, S_END = S_DTV + 128 * 4;
static_assert(S_END <= LDS_BYTES - 64, "ssd lds");
__device__ __forceinline__ bf16x8 ssd_trfrag(const LAS unsigned char* p, int pitch) {
    const s16x4 lo = __builtin_bit_cast(s16x4, __builtin_amdgcn_ds_read_tr16_b64_v4i16((LAS v4i16s_t*)p));
    const s16x4 hi = __builtin_bit_cast(s16x4, __builtin_amdgcn_ds_read_tr16_b64_v4i16((LAS v4i16s_t*)(p + 4 * pitch)));
    return __builtin_shufflevector(lo, hi, 0, 1, 2, 3, 4, 5, 6, 7);
}
__device__ __forceinline__ void ssd_item(CP& P, int L, int sq, int hd, int dir, LAS unsigned char* lds) {
    const int tid = opaque_tid(), lane = tid & 63, wid = __builtin_amdgcn_readfirstlane(tid >> 6), r = lane & 31, hi = lane >> 5;
    int sstart, slen; seq_of(sq, sstart, slen); const int nc = slen / 128, g = hd / 6;
    const bf16_t* xbc = (const bf16_t*)(P.ws + WS_XBC); const float* DT = (const float*)(P.ws + WS_DT);
    bf16_t* Y = (bf16_t*)(P.ws + (dir ? WS_YB : WS_YF));
    const float Aneg = -__expf(P.in[I_ALOG][L * 24 + dir * 12 + hd]), dtb = P.in[I_DTB][L * 24 + dir * 12 + hd]; const int dcol = dir * 12 + hd;
    LAS float* AS = (LAS float*)(lds + S_AS); LAS float* DTV = (LAS float*)(lds + S_DTV);
    f32x16 st;
#pragma unroll
    for (int i = 0; i < 16; ++i) st[i] = 0.f;
    for (int i = tid; i < 64 * SP / 4; i += 512) ((LAS unsigned*)(lds + S_PV))[i] = 0u;
    const int crow_ = tid >> 4, cch = tid & 15;
    const int xrow_ = tid >> 3, xch = tid & 7;
    const int lb = wid >> 1, pb = wid & 1, nb = wid >> 1;
    const int trq = (lane & 15) >> 2, trb = ((lane >> 4) & 1) * 32 + (lane & 3) * 8;
    const int xdo = S_XD + (8 * hi + trq) * SXP + 64 * pb + trb;
    const int bdo = S_BD + (8 * hi + trq) * SP + 64 * nb + trb;
    u32x4 cv[4], bv[4], xv[2]; float r0 = 0.f, r1 = 0.f;
#define SSD_LOAD(tk) do { const bf16_t* rp_ = xbc + (size_t)(tk) * XBC_W; \
        _Pragma("unroll") for (int i = 0; i < 4; ++i) { cv[i] = *(const u32x4*)(rp_ + (size_t)(crow_ + 32 * i) * XBC_W + 1024 + g * 128 + cch * 8); bv[i] = *(const u32x4*)(rp_ + (size_t)(crow_ + 32 * i) * XBC_W + 768 + g * 128 + cch * 8); } \
        _Pragma("unroll") for (int i = 0; i < 2; ++i) xv[i] = *(const u32x4*)(rp_ + (size_t)(xrow_ + 64 * i) * XBC_W + hd * 64 + xch * 8); \
        if (wid == 0) { r0 = DT[(size_t)((tk) + lane) * 32 + dcol]; r1 = DT[(size_t)((tk) + 64 + lane) * 32 + dcol]; } } while (0)
    SSD_LOAD(sstart + (dir ? nc - 1 : 0) * 128);
    for (int ci = 0; ci < nc; ++ci) {
        const int c = dir ? nc - 1 - ci : ci; const int tok0 = sstart + c * 128;
#pragma unroll
        for (int i = 0; i < 4; ++i) { const int row = crow_ + 32 * i; *(LAS u32x4*)(lds + S_CM + row * SP + cch * 16) = cv[i]; *(LAS u32x4*)(lds + S_BM + row * SP + cch * 16) = bv[i]; }
        if (wid == 0) {
            const float q0 = r0 + dtb, q1 = r1 + dtb;
            const float d0 = q0 > 20.f ? q0 : log1pf(__expf(q0)), d1 = q1 > 20.f ? q1 : log1pf(__expf(q1));
            const float x0 = d0 * Aneg, x1 = d1 * Aneg; float p0 = x0, p1 = x1;
#pragma unroll
            for (int o = 1; o < 64; o <<= 1) { const float t0 = __shfl_up(p0, o), t1 = __shfl_up(p1, o); if (lane >= o) { p0 += t0; p1 += t1; } }
            const float tot0 = __shfl(p0, 63), tot1 = __shfl(p1, 63); p1 += tot0; const float total = tot0 + tot1;
            float a0 = p0, a1 = p1; if (dir) { a0 = total - p0 + x0; a1 = total - p1 + x1; }
            AS[lane] = a0; AS[64 + lane] = a1; DTV[lane] = d0; DTV[64 + lane] = d1; if (lane == 0) AS[128] = total;
        }
        __syncthreads();
        { const float aend = AS[128];
#pragma unroll
          for (int i = 0; i < 4; ++i) { const int row = crow_ + 32 * i; const float dec = __expf(aend - AS[row]);
              float f[8]; unpack8(bv[i], f); u32x4 w; w.x = cvtpk(f[0] * dec, f[1] * dec); w.y = cvtpk(f[2] * dec, f[3] * dec); w.z = cvtpk(f[4] * dec, f[5] * dec); w.w = cvtpk(f[6] * dec, f[7] * dec);
              *(LAS u32x4*)(lds + S_BD + row * SP + cch * 16) = w; }
#pragma unroll
          for (int i = 0; i < 2; ++i) { const int row = xrow_ + 64 * i; const float dtv = DTV[row]; float f[8]; unpack8(xv[i], f);
              u32x4 w; w.x = cvtpk(f[0] * dtv, f[1] * dtv); w.y = cvtpk(f[2] * dtv, f[3] * dtv); w.z = cvtpk(f[4] * dtv, f[5] * dtv); w.w = cvtpk(f[6] * dtv, f[7] * dtv);
              *(LAS u32x4*)(lds + S_XD + row * SXP + xch * 16) = w; } }
        if (ci + 1 < nc) SSD_LOAD(sstart + (dir ? nc - 2 - ci : ci + 1) * 128);
        __syncthreads();
        {   const int lrow = 32 * lb + r; const float a_l = AS[lrow];
            f32x16 yd, yo;
#pragma unroll
            for (int i = 0; i < 16; ++i) { yd[i] = 0.f; yo[i] = 0.f; }
            const int sb0 = dir ? lb : 0, sb1 = dir ? 4 : lb + 1;
#pragma unroll
            for (int sb = 0; sb < 4; ++sb) if (sb >= sb0 && sb < sb1) {
                f32x16 cb;
#pragma unroll
                for (int i = 0; i < 16; ++i) cb[i] = 0.f;
#pragma unroll
                for (int ks = 0; ks < 8; ++ks) { const bf16x8 av = *(const LAS bf16x8*)(lds + S_BM + (32 * sb + r) * SP + (16 * ks + 8 * hi) * 2);
                    const bf16x8 bv2 = *(const LAS bf16x8*)(lds + S_CM + lrow * SP + (16 * ks + 8 * hi) * 2); cb = MFMA32(av, bv2, cb); }
#pragma unroll
                for (int i = 0; i < 16; ++i) { const int sr = 32 * sb + crow(i, hi); const bool ok = dir ? (sr >= lrow) : (sr <= lrow); const float gv = cb[i] * __expf(a_l - AS[sr]); cb[i] = ok ? gv : 0.f; }
#pragma unroll
                for (int s2 = 0; s2 < 2; ++s2) { const LAS unsigned char* xp = lds + S_XD + (32 * sb + 16 * s2 + 4 * hi + trq) * SXP + 64 * pb + trb;
                    const s16x4 lo = __builtin_bit_cast(s16x4, __builtin_amdgcn_ds_read_tr16_b64_v4i16((LAS v4i16s_t*)xp));
                    const s16x4 hi4 = __builtin_bit_cast(s16x4, __builtin_amdgcn_ds_read_tr16_b64_v4i16((LAS v4i16s_t*)(xp + 8 * SXP)));
                    const bf16x8 xa = __builtin_shufflevector(lo, hi4, 0, 1, 2, 3, 4, 5, 6, 7);
                    yd = MFMA32(xa, pack_step(cb, s2), yd); }
            }
            const float cd = __expf(AS[128]);
#pragma unroll
            for (int i = 0; i < 16; ++i) st[i] *= cd;
#pragma unroll
            for (int ks = 0; ks < 8; ++ks) { const bf16x8 av = *(const LAS bf16x8*)(lds + S_PV + (32 * pb + r) * SP + (16 * ks + 8 * hi) * 2);
                const bf16x8 bv2 = *(const LAS bf16x8*)(lds + S_CM + lrow * SP + (16 * ks + 8 * hi) * 2);
                const bf16x8 xa = ssd_trfrag(lds + xdo + 16 * ks * SXP, SXP); const bf16x8 bb = ssd_trfrag(lds + bdo + 16 * ks * SP, SP);
                yo = MFMA32(av, bv2, yo); st = MFMA32(xa, bb, st); }
            const float el = __expf(a_l);
            bf16_t* yp = Y + (size_t)(tok0 + lrow) * SSD_W + hd * 64 + 32 * pb + 4 * hi;
#pragma unroll
            for (int g4 = 0; g4 < 4; ++g4) { u32x2 w; w.x = cvtpk(yd[4 * g4] + el * yo[4 * g4], yd[4 * g4 + 1] + el * yo[4 * g4 + 1]); w.y = cvtpk(yd[4 * g4 + 2] + el * yo[4 * g4 + 2], yd[4 * g4 + 3] + el * yo[4 * g4 + 3]);
                *(u32x2*)(yp + 8 * g4) = w; }
        }
        __syncthreads();
#pragma unroll
        for (int i = 0; i < 16; ++i) *(LAS bf16_t*)(lds + S_PV + (32 * pb + crow(i, hi)) * SP + (32 * nb + r) * 2) = f2bf(st[i]);
    }
    __syncthreads();
#undef SSD_LOAD
}

typedef short v4i16_t __attribute__((ext_vector_type(4)));
constexpr int A_SLOT = 32768, A_VI = 16384, A_NSLOT = 4, A_TBL = A_NSLOT * A_SLOT, A_O2P = 132;
static_assert(A_TBL + 260 * 4 <= LDS_BYTES - 64 && 128 * A_O2P * 4 <= A_TBL, "attn lds");
__device__ __forceinline__ void attn_item(CP& P, int L, int sq, int hh, int qt, float lam, float lam_init, LAS unsigned char* lds) {
    const int tid = opaque_tid(), lane = tid & 63, wid = __builtin_amdgcn_readfirstlane(tid >> 6), r = lane & 31, hi = lane >> 5, map = wid >> 2, wq = wid & 3;
    int sstart, slen; seq_of(sq, sstart, slen); const int ntiles = slen / 64;
    const bf16_t* proj = (const bf16_t*)(P.ws + WS_PROJ); bf16_t* mix = (bf16_t*)(P.ws + WS_MIX);
    LAS float* tbl = (LAS float*)(lds + A_TBL);
    if (tid < 257) { const int rel = tid - 128; const int n = rel < 0 ? -rel : rel; int bk;
        if (n < 8) bk = n; else { int k = (31 - __builtin_clz((unsigned)(n * n))) - 6; bk = 8 + k; if (bk > 15) bk = 15; }
        if (rel > 0) bk += 16;
        tbl[tid] = P.in[I_RELB][bk * 6 + hh] * LOG2E; }
    const int qpos = qt * 128 + wq * 32 + r;
    const float SC = 0.125f * LOG2E;
    bf16x8 qf[4];
    { const bf16_t* qp = proj + (size_t)(sstart + qpos) * PROJ_PITCH + QOFF + hh * 128 + map * 64 + hi * 8;
#pragma unroll
      for (int s = 0; s < 4; ++s) { const u32x4 w = *(const u32x4*)(qp + 16 * s); float f[8]; unpack8(w, f); u32x4 o4;
          o4.x = cvtpk(f[0] * SC, f[1] * SC); o4.y = cvtpk(f[2] * SC, f[3] * SC); o4.z = cvtpk(f[4] * SC, f[5] * SC); o4.w = cvtpk(f[6] * SC, f[7] * SC); qf[s] = __builtin_bit_cast(bf16x8, o4); } }
    f32x16 o[4];
#pragma unroll
    for (int c = 0; c < 4; ++c)
#pragma unroll
        for (int i = 0; i < 16; ++i) o[c][i] = 0.f;
    float mref = 0.f, lrun = 0.f;
    const bf16_t* gk[2]; const bf16_t* gv[2];
#pragma unroll
    for (int i = 0; i < 2; ++i) { const int n = 2 * wid + i;
        { const int rr = 8 * (n & 7) + (lane >> 3), c = (lane & 7) ^ ((rr >> 1) & 7); gk[i] = proj + (size_t)(sstart + rr) * PROJ_PITCH + KOFF + hh * 128 + (n >> 3) * 64 + c * 8; }
        { const int rr = 4 * n + (lane >> 4), ch = (lane & 15) ^ (4 * (rr & 3)); gv[i] = proj + (size_t)(sstart + rr) * PROJ_PITCH + VOFF + hh * 128 + ch * 8; } }
#define ATT_DMA(t, slot) do { const size_t to_ = (size_t)(t) * 64 * PROJ_PITCH; LAS unsigned char* sd_ = lds + (slot) * A_SLOT + wid * 2048; \
        _Pragma("unroll") for (int i = 0; i < 2; ++i) { \
            __builtin_amdgcn_global_load_lds((const unsigned*)(gk[i] + to_), (LAS unsigned*)(sd_ + i * 1024), 16, 0, 0); \
            __builtin_amdgcn_global_load_lds((const unsigned*)(gv[i] + to_), (LAS unsigned*)(sd_ + A_VI + i * 1024), 16, 0, 0); } } while (0)
#define ATT_WAITBAR(N) do { asm volatile("s_waitcnt vmcnt(" #N ") lgkmcnt(0)" ::: "memory"); __builtin_amdgcn_s_barrier(); asm volatile("" ::: "memory"); } while (0)
    const int q0w = qt * 128 + wq * 32;
    const int m7 = (r >> 1) & 7;
    const int kfo = map * 8192 + r * 128;
    int kso[4];
#pragma unroll
    for (int s = 0; s < 4; ++s) kso[s] = ((2 * s + hi) ^ m7) * 16;
    const int vq = (lane & 15) >> 2;
    const int vfo = A_VI + (4 * hi + vq) * 256 + ((lane >> 4) & 1) * 32 + (lane & 3) * 8;
    bf16x8 pf[2][2];
    f32x16 p[2];
#define SB() __builtin_amdgcn_sched_barrier(0)
#define ATT_KRD(sbuf) do { const unsigned ka_ = (unsigned)(size_t)(lds + (sbuf) * A_SLOT + kfo); \
        _Pragma("unroll") for (int s_ = 0; s_ < 4; ++s_) { const unsigned kas_ = ka_ + (unsigned)kso[s_]; \
            asm volatile("ds_read_b128 %0, %1" : "=&v"(kf[s_]) : "v"(kas_) : "memory"); \
            asm volatile("ds_read_b128 %0, %1 offset:4096" : "=&v"(kf[4 + s_]) : "v"(kas_) : "memory"); } } while (0)
#define ATT_QKM(t) do { _Pragma("unroll") for (int kb = 0; kb < 2; ++kb) _Pragma("unroll") for (int i = 0; i < 16; ++i) p[kb][i] = cinit_; \
        SB(); __builtin_amdgcn_s_setprio(1); \
        _Pragma("unroll") for (int s_ = 0; s_ < 4; ++s_) _Pragma("unroll") for (int kb = 0; kb < 2; ++kb) p[kb] = MFMA32(kf[kb * 4 + s_], qf[s_], p[kb]); \
        __builtin_amdgcn_s_setprio(0); SB(); } while (0)
#define ATT_TR(dst, addr, off) asm volatile("ds_read_b64_tr_b16 %0, %1 offset:%c2" : "=&v"(dst) : "v"(addr), "i"(off) : "memory")
#define ATT_LWAIT() asm volatile("s_waitcnt lgkmcnt(0)" ::: "memory")
#define ATT_VRD(dst, c) do { const unsigned va_ = vaddr_ + 64u * (unsigned)((c) ^ vq); \
        ATT_TR(dst[0], va_, 0);     ATT_TR(dst[1], va_, 2048);  ATT_TR(dst[2], va_, 4096);  ATT_TR(dst[3], va_, 6144); \
        ATT_TR(dst[4], va_, 8192);  ATT_TR(dst[5], va_, 10240); ATT_TR(dst[6], va_, 12288); ATT_TR(dst[7], va_, 14336); } while (0)
#define ATT_VMM(src, c) do { __builtin_amdgcn_s_setprio(1); _Pragma("unroll") for (int kb = 0; kb < 2; ++kb) _Pragma("unroll") for (int s_ = 0; s_ < 2; ++s_) { \
            const bf16x8 vb_ = __builtin_shufflevector(src[2 * (kb * 2 + s_)], src[2 * (kb * 2 + s_) + 1], 0, 1, 2, 3, 4, 5, 6, 7); \
            o[c] = MFMA32(vb_, pf[kb][s_], o[c]); } __builtin_amdgcn_s_setprio(0); } while (0)
#define ATT_VMM2(srca, ca, srcb, cb) do { __builtin_amdgcn_s_setprio(1); _Pragma("unroll") for (int kb = 0; kb < 2; ++kb) _Pragma("unroll") for (int s_ = 0; s_ < 2; ++s_) { \
            const bf16x8 va_ = __builtin_shufflevector(srca[2 * (kb * 2 + s_)], srca[2 * (kb * 2 + s_) + 1], 0, 1, 2, 3, 4, 5, 6, 7); \
            const bf16x8 vb_ = __builtin_shufflevector(srcb[2 * (kb * 2 + s_)], srcb[2 * (kb * 2 + s_) + 1], 0, 1, 2, 3, 4, 5, 6, 7); \
            o[ca] = MFMA32(va_, pf[kb][s_], o[ca]); o[cb] = MFMA32(vb_, pf[kb][s_], o[cb]); } __builtin_amdgcn_s_setprio(0); } while (0)
#define ATT_PV(sbuf) do { const unsigned vaddr_ = (unsigned)(size_t)(lds + (sbuf) * A_SLOT + vfo); s16x4 va0_[8], va1_[8]; \
        ATT_VRD(va0_, 0); ATT_VRD(va1_, 1); ATT_LWAIT(); SB(); ATT_VMM2(va0_, 0, va1_, 1); SB(); \
        ATT_VRD(va0_, 2); ATT_VRD(va1_, 3); ATT_LWAIT(); SB(); ATT_VMM2(va0_, 2, va1_, 3); SB(); } while (0)
#define ATT_SOFTMAX(t) do { const int k0_ = (t) * 64; \
        if (!far_) { _Pragma("unroll") for (int kb = 0; kb < 2; ++kb) _Pragma("unroll") for (int i = 0; i < 16; ++i) { \
            int rel_ = k0_ + kb * 32 + crow(i, hi) - qpos; rel_ = rel_ < -128 ? -128 : (rel_ > 128 ? 128 : rel_); p[kb][i] += tbl[rel_ + 128]; } } \
        float mx_; bool resc_; \
        if ((t) == 0) { mx_ = fmaxf(p[0][0], p[1][0]); _Pragma("unroll") for (int i = 1; i < 16; ++i) mx_ = fmaxf(mx_, fmaxf(p[0][i], p[1][i])); mx_ = fmaxf(mx_, __shfl_xor(mx_, 32)); resc_ = true; } \
        else { int im_ = __float_as_int(p[0][0]);   \
            _Pragma("unroll") for (int i = 0; i < 16; ++i) { const int a_ = __float_as_int(p[0][i]), b_ = __float_as_int(p[1][i]); im_ = (im_ > a_ ? im_ : a_); im_ = (im_ > b_ ? im_ : b_); } \
            const int io_ = __shfl_xor(im_, 32); im_ = im_ > io_ ? im_ : io_; mx_ = __int_as_float(im_); resc_ = __any(im_ > 0x41000000); } \
        if (resc_) { \
            const float dl_ = ((t) == 0) ? mx_ : (mx_ > 0.f ? mx_ : 0.f); mref += dl_; const float f_ = __builtin_amdgcn_exp2f(-dl_); lrun *= f_; \
            _Pragma("unroll") for (int kb = 0; kb < 2; ++kb) _Pragma("unroll") for (int i = 0; i < 16; ++i) p[kb][i] -= dl_; \
            _Pragma("unroll") for (int c = 0; c < 4; ++c) _Pragma("unroll") for (int i = 0; i < 16; ++i) o[c][i] *= f_; } \
        f32x2 ls_ = {0.f, 0.f}; \
        _Pragma("unroll") for (int i = 0; i < 16; ++i) { f32x2 e_; e_.x = __builtin_amdgcn_exp2f(p[0][i]); e_.y = __builtin_amdgcn_exp2f(p[1][i]); p[0][i] = e_.x; p[1][i] = e_.y; ls_ += e_; } \
        lrun += ls_.x + ls_.y; \
        _Pragma("unroll") for (int kb = 0; kb < 2; ++kb) _Pragma("unroll") for (int s_ = 0; s_ < 2; ++s_) pf[kb][s_] = pack_step(p[kb], s_); } while (0)
    bool far_ = false;
    ATT_DMA(0, 0); ATT_DMA((1 < ntiles ? 1 : ntiles - 1), 1);
    ATT_WAITBAR(4);
    bf16x8 kf[8];
    for (int t = 0; t < ntiles; ++t) {
        { const int tn = (t + 2 < ntiles) ? t + 2 : ntiles - 1; ATT_DMA(tn, (t + 2) & 3); }
        const int k0_ = t * 64; const bool farR_ = (k0_ - (q0w + 31) >= 128), farL_ = (q0w - (k0_ + 63) >= 128); far_ = farR_ || farL_;
        const float cinit_ = (far_ ? (farR_ ? tbl[256] : tbl[0]) : 0.f) - mref;
        if (t > 0) {
            const unsigned vaddr_ = (unsigned)(size_t)(lds + ((t - 1) & 3) * A_SLOT + vfo); s16x4 va0_[8], va1_[8];
            ATT_VRD(va0_, 0); ATT_VRD(va1_, 1); ATT_LWAIT(); SB();
            ATT_VMM2(va0_, 0, va1_, 1); SB();
            ATT_VRD(va0_, 2); ATT_VRD(va1_, 3); ATT_LWAIT(); ATT_KRD(t & 3); SB();
            ATT_VMM2(va0_, 2, va1_, 3); SB(); ATT_LWAIT(); SB();
        } else { ATT_KRD(0); ATT_LWAIT(); SB(); }
        ATT_QKM(t);
        ATT_SOFTMAX(t);
        ATT_WAITBAR(4);
    }
    ATT_PV((ntiles - 1) & 3);
    __builtin_amdgcn_s_setprio(0);
    asm volatile("s_waitcnt vmcnt(0)" ::: "memory");
    __syncthreads();
#undef ATT_DMA
#undef ATT_WAITBAR
#undef ATT_KRD
#undef ATT_QKM
#undef ATT_PV
#undef ATT_VRD
#undef ATT_VMM
#undef ATT_VMM2
#undef ATT_TR
#undef ATT_LWAIT
#undef ATT_SOFTMAX
#undef SB
    lrun += __shfl_xor(lrun, 32);
    const float inv = 1.f / lrun;
    LAS float* O2 = (LAS float*)lds;
    if (map == 1) {
#pragma unroll
        for (int c = 0; c < 4; ++c)
#pragma unroll
            for (int i = 0; i < 16; ++i) O2[(wq * 32 + r) * A_O2P + 32 * c + crow(i, hi)] = o[c][i] * inv;
    }
    __syncthreads();
    if (map == 0) {
        float ss = 0.f;
#pragma unroll
        for (int c = 0; c < 4; ++c)
#pragma unroll
            for (int i = 0; i < 16; ++i) { const float v = o[c][i] * inv - lam * O2[(wq * 32 + r) * A_O2P + 32 * c + crow(i, hi)]; o[c][i] = v; ss += v * v; }
        ss += __shfl_xor(ss, 32);
        const float rstd = rsqrtf(ss * (1.f / 128.f) + EPS) * (1.f - lam_init);
        const float* sg = P.in[I_SUBLN] + L * 128;
        bf16_t* op = mix + (size_t)(sstart + qpos) * DM + 1280 + hh * 128;
#pragma unroll
        for (int c = 0; c < 4; ++c)
#pragma unroll
            for (int gq = 0; gq < 4; ++gq) { const int dv = 32 * c + 8 * gq + 4 * hi; const f32x4 gg = *(const f32x4*)(sg + dv);
                u32x2 w; w.x = cvtpk(o[c][4 * gq] * rstd * gg.x, o[c][4 * gq + 1] * rstd * gg.y); w.y = cvtpk(o[c][4 * gq + 2] * rstd * gg.z, o[c][4 * gq + 3] * rstd * gg.w);
                *(u32x2*)(op + dv) = w; }
    }
    __syncthreads();
}

#define XB_TMO      128
#define XB_XCNT(j)  (256  + 64 * (j))
#define XB_XSUB(j)  (1280 + 64 * (j))
#define XB_XGEN(j)  (2304 + 64 * (j))
#define XB_TOP      3328
#define XB_TOPGEN   3392
#define XCD_BAR_WORDS 3456
#define XB_SPIN_CAP (1u << 18)
__device__ __forceinline__ unsigned xb_ld(unsigned* p)              { return __hip_atomic_load(p, __ATOMIC_RELAXED, __HIP_MEMORY_SCOPE_AGENT); }
__device__ __forceinline__ unsigned xb_add(unsigned* p, unsigned v) { return __hip_atomic_fetch_add(p, v, __ATOMIC_RELAXED, __HIP_MEMORY_SCOPE_AGENT); }
__device__ __forceinline__ unsigned xb_xcc_id() { return (unsigned)__builtin_amdgcn_s_getreg((3 << 11) | 20) & 0xFu; }
#define XB_SPIN(cond, bar) do { unsigned _sp = 0; while (cond) { __builtin_amdgcn_s_sleep(1); \
    if ((++_sp & 255u) == 0u) { if (xb_ld(&(bar)[XB_TMO])) break; if (_sp > XB_SPIN_CAP) { atomicAdd(&(bar)[XB_TMO], 1u); break; } } } } while (0)
struct XcdBarrier { unsigned* bar; unsigned x; volatile LAS unsigned* st; };
__device__ __forceinline__ XcdBarrier xcd_barrier_post(unsigned* bar, volatile LAS unsigned* st) {
    XcdBarrier b; b.bar = bar; b.x = xb_xcc_id(); b.st = st;
    if (threadIdx.x == 0) (void)xb_add(&bar[XB_XCNT(b.x)], 1u);
    return b;
}
__device__ __forceinline__ void xcd_barrier_complete(unsigned* bar, unsigned x, unsigned& nloc, unsigned& nx) {
    const unsigned G = gridDim.x * gridDim.y * gridDim.z;
    unsigned sum, cnt, mine, sp = 0u;
    for (;;) {
        sum = 0u; cnt = 0u; mine = 0u;
#pragma unroll
        for (unsigned j = 0; j < 16; ++j) { const unsigned c = xb_ld(&bar[XB_XCNT(j)]); sum += c; cnt += (c > 0u) ? 1u : 0u; mine = (j == x) ? c : mine; }
        if (sum == G) break;
        __builtin_amdgcn_s_sleep(1);
        if ((++sp & 255u) == 0u) { if (xb_ld(&bar[XB_TMO])) break; if (sp > XB_SPIN_CAP) { atomicAdd(&bar[XB_TMO], 1u); break; } }
    }
    nloc = mine > 0u ? mine : 1u; nx = cnt > 0u ? cnt : 1u;
}
__device__ __forceinline__ void xcd_barrier(const XcdBarrier& b) {
    asm volatile("s_waitcnt vmcnt(0)" ::: "memory");
    __syncthreads();
    if (threadIdx.x == 0) {
        unsigned* bar = b.bar;
        __builtin_amdgcn_s_waitcnt(0);
        unsigned nloc = b.st[0], nx = b.st[1];
        if (nloc == 0u) { xcd_barrier_complete(bar, b.x, nloc, nx); b.st[0] = nloc; b.st[1] = nx; }
        const unsigned old = xb_add(&bar[XB_XSUB(b.x)], 1u);
        const unsigned gen = old / nloc;
        if (old + 1u == (gen + 1u) * nloc) {
            __builtin_amdgcn_fence(__ATOMIC_RELEASE, "agent");
            asm volatile("s_waitcnt vmcnt(0)" ::: "memory");
            const unsigned og = xb_add(&bar[XB_TOP], 1u);
            const unsigned tg = og / nx;
            if (og + 1u == (tg + 1u) * nx) xb_add(&bar[XB_TOPGEN], 1u);
            else XB_SPIN(xb_ld(&bar[XB_TOPGEN]) == tg, bar);
            __builtin_amdgcn_fence(__ATOMIC_ACQUIRE, "agent");
            xb_add(&bar[XB_XGEN(b.x)], 1u);
            asm volatile("s_waitcnt vmcnt(0)" ::: "memory");
        } else {
            XB_SPIN(xb_ld(&bar[XB_XGEN(b.x)]) == gen, bar);
            __builtin_amdgcn_fence(__ATOMIC_ACQUIRE, "agent");
            asm volatile("s_waitcnt vmcnt(0)" ::: "memory");
        }
    }
    __syncthreads();
}

__global__ void __launch_bounds__(512, 2) hybrid_fwd(Params P0) {
    extern __shared__ __attribute__((aligned(16))) unsigned char lds_raw[];
    LAS unsigned char* lds = (LAS unsigned char*)lds_raw;
    cg::grid_group grid = cg::this_grid();
    const int G = gridDim.x, bx = blockIdx.x, NGW = G * 8;
    XcdBarrier xbar; xbar.bar = nullptr; xbar.x = 0; xbar.st = nullptr;
    if (P0.ph_hi - P0.ph_lo > 1) {
        unsigned* bw = (unsigned*)(P0.ws + WS_CTL) + 4096;
        if (bx == 0) for (int i = threadIdx.x; i < XCD_BAR_WORDS; i += 512) __hip_atomic_store(bw + i, 0u, __ATOMIC_RELAXED, __HIP_MEMORY_SCOPE_AGENT);
        volatile LAS unsigned* st = (volatile LAS unsigned*)(lds + LDS_BYTES - 32);
        if (threadIdx.x == 0) { st[0] = 0u; st[1] = 0u; }
        grid.sync();
        xbar = xcd_barrier_post(bw, st);
    }
    for (int ph = P0.ph_lo; ph < P0.ph_hi; ++ph) {
        const int L = ph / NPH_LAYER; int sub = ph % NPH_LAYER; int rep = 0; if (PROBE_SUB >= 0 && sub > PROBE_SUB) { rep = (sub == PROBE_SUB + 1); --sub; } if (ph == NPHASES - 1) sub = 99;
        const int tid = opaque_tid(), lane = tid & 63, wid = __builtin_amdgcn_readfirstlane(tid >> 6), gw = bx * 8 + wid;
        CP* pp = (CP*)__builtin_amdgcn_kernarg_segment_ptr(); asm volatile("" : "+s"(pp)); CP& P = *pp;
        unsigned* ctl = (unsigned*)(P.ws + WS_CTL); u64_t* RSS = (u64_t*)(P.ws + WS_RSS);
        bf16_t* Hin = (bf16_t*)P.out + (L == 0 ? (size_t)0 : (size_t)T * DM); bf16_t* Hout = (L == 0) ? (bf16_t*)P.out + (size_t)T * DM : (bf16_t*)(P.ws + WS_HB);
        if (sub == 0 && PHON(0)) {
            if (bx == 0 && tid == 0) {
                ctl[64 + 2 * L] = 0u; ctl[64 + 2 * L + 1] = 0u;
                float s1 = 0.f, s2 = 0.f;
                for (int i = 0; i < 64; ++i) { s1 += P.in[I_LQ1][L * 64 + i] * P.in[I_LK1][L * 64 + i]; s2 += P.in[I_LQ2][L * 64 + i] * P.in[I_LK2][L * 64 + i]; }
                const float lam_init = 0.8f - 0.6f * expf(-0.3f * (float)L);
                ((float*)ctl)[128 + L] = expf(s1) - expf(s2) + lam_init;
            }
            LAS float* scr = (LAS float*)(lds + wid * 16384);
            constexpr int I_IN = 32 * 176, I_OUT = 32 * 64, I_UP = 32 * 256, I_DN = 128 * 64, I_GT = 32 * 64, I_PL = 4 * 64, NIT = I_IN + I_OUT + I_UP + I_DN + I_GT + I_PL;
            for (int it = gw; it < NIT; it += NGW) { int q = it;
                if (q < I_IN) { transpose_item<true>(P.in[I_WIN] + (size_t)L * DM * IN_COLS, P.in[I_NMIXG] + L * DM, DM, IN_COLS, 176, (bf16_t*)(P.ws + WS_WIN), scr, q, lane); continue; } q -= I_IN;
                if (q < I_OUT) { transpose_item<false>(P.in[I_WOUT] + (size_t)L * DM * DM, nullptr, DM, DM, 64, (bf16_t*)(P.ws + WS_WOUT), scr, q, lane); continue; } q -= I_OUT;
                if (q < I_UP) { transpose_item<false>(P.in[I_WUP] + (size_t)L * DM * DFF, P.in[I_NMLPG] + L * DM, DM, DFF, 256, (bf16_t*)(P.ws + WS_WUP), scr, q, lane); continue; } q -= I_UP;
                if (q < I_DN) { transpose_item<false>(P.in[I_WDN] + (size_t)L * DFF * DM, nullptr, DFF, DM, 64, (bf16_t*)(P.ws + WS_WDN), scr, q, lane); continue; } q -= I_DN;
                if (q < I_GT) { transpose_item<false>(P.in[I_WG] + (size_t)L * DM * DM, P.in[I_NPLEG] + L * DM, DM, DM, 64, (bf16_t*)(P.ws + WS_WG), scr, q, lane); continue; } q -= I_GT;
                transpose_item<false>(P.in[I_WPLE] + (size_t)L * PLE * DM, nullptr, PLE, DM, 64, (bf16_t*)(P.ws + WS_WPLE), scr, q, lane);
            }
            if (L == 0) {
                { const int nth = G * 512, nit = (6 * T + nth - 1) / nth; for (int k = 0; k < nit; ++k) { const int i = k * nth + bx * 512 + tid; if (i < 6 * T) RSS[i] = 0ull; } }
                for (int m = gw; m < T; m += NGW) {
                    const float* src = (m < TP) ? P.in[I_XP] + (size_t)m * DM : P.in[I_XS] + (size_t)(m - TP) * DM;
                    prep_row(src, Hin + (size_t)m * DM, RSS + 6 * T + m, lane);
                }
            }
        } else if ((sub == 1 || sub == 5 || sub == 6 || sub == 7 || sub == 8 || sub == 9) && PHON(1)) {
            if (sub == 7) {
                bf16_t* PB = (bf16_t*)(P.ws + WS_PB);
                for (int m = gw; m < T; m += NGW) {
                    const float* pr = (m < TP) ? P.in[I_PP] + ((size_t)L * TP + m) * PLE : P.in[I_PS] + ((size_t)L * TS + (m - TP)) * PLE;
                    const f32x4 v = *((const f32x4*)pr + lane); u32x2 w; w.x = cvtpk(v.x, v.y); w.y = cvtpk(v.z, v.w); *((u32x2*)(PB + (size_t)m * PLE) + lane) = w; }
            }
            pg8::Gemm g; pg8::EpiAny E; E.O = nullptr; E.ldc = DM; E.Hs = Hin; E.dt = (float*)(P.ws + WS_DT); E.PE = (const bf16_t*)(P.ws + WS_PE); E.perm = true; g.M = T;
            E.HB = Hin; E.rin = RSS; E.rout = RSS;
            const bf16_t* HBp = Hin;
            if (sub == 1)      { g.A = HBp; g.Bt = (const bf16_t*)(P.ws + WS_WIN); g.N = PROJ_PITCH; g.K = DM; E.kind = 0; E.O = (bf16_t*)(P.ws + WS_PROJ); E.ldc = PROJ_PITCH; E.rin = RSS + (L == 0 ? 6 : 2) * T; }
            else if (sub == 5) { g.A = (const bf16_t*)(P.ws + WS_MIX); g.Bt = (const bf16_t*)(P.ws + WS_WOUT); g.N = DM; g.K = DM; E.kind = 1; E.rout = RSS + (3 * L + 0) * T; }
            else if (sub == 6) { g.A = HBp; g.Bt = (const bf16_t*)(P.ws + WS_WUP); g.N = DFF; g.K = DM; E.kind = 2; E.O = (bf16_t*)(P.ws + WS_HID); E.ldc = DFF; E.rin = RSS + (3 * L + 0) * T; }
            else if (sub == 7) { g.A = (const bf16_t*)(P.ws + WS_HID); g.Bt = (const bf16_t*)(P.ws + WS_WDN); g.N = DM; g.K = DFF; E.kind = 1; E.rout = RSS + (3 * L + 1) * T; }
            else if (sub == 8) { g.A = (const bf16_t*)(P.ws + WS_PB); g.Bt = (const bf16_t*)(P.ws + WS_WPLE); g.N = DM; g.K = PLE; E.kind = 3; E.O = (bf16_t*)(P.ws + WS_PE); E.ldc = DM; }
            else               { g.A = HBp; g.Bt = (const bf16_t*)(P.ws + WS_WG); g.N = DM; g.K = DM; E.kind = 4; E.rin = RSS + (3 * L + 1) * T; E.rout = RSS + (3 * L + 2) * T; E.HB = Hout; }
            pg8::StaticOrder S; S.init(T, g.N, G, bx);
            pg8::gemm_phase<pg8::EpiAny>(lds, g, S, E);
            asm volatile("s_waitcnt vmcnt(0)" ::: "memory");
        } else if (sub == 2 && PHON(2)) {
            for (int it = bx; it < (T / 32 + 2) / 3; it += G) xbc_conv_item(P, L, it);
            for (int it = bx; it < T / 32; it += G) conv_module_item(P, L, it, lds);
        } else if (sub == 3 && PHON(3)) {
            const float lam = __uint_as_float(__hip_atomic_load(ctl + 128 + L, __ATOMIC_RELAXED, __HIP_MEMORY_SCOPE_AGENT)); const float lam_init = 0.8f - 0.6f * expf(-0.3f * (float)L);
            LAS int* qslot = (LAS int*)(lds + LDS_BYTES - 16);
            for (;;) {
                if (tid == 0) *qslot = (int)atomicAdd(&ctl[64 + 2 * L + rep], 1u);
                __syncthreads();
                const int item = *qslot;
                __syncthreads();
                if (item >= 288 + 1920) break;
                if (item < 288) { int sq, rem; if (item < 192) { sq = 4 + item / 24; rem = item % 24; } else { sq = (item - 192) / 24; rem = (item - 192) % 24; }
                    if (PHON(12)) ssd_item(P, L, sq, rem % 12, rem / 12, lds);
                } else { int sq, hh, qt;
                    if (item < 288 + 1536) { const int j = item - 288; sq = 4 + j / 192; hh = (j % 192) / 32; qt = j % 32; }
                    else { const int j = item - 288 - 1536; sq = j / 96; hh = (j % 96) / 16; qt = j % 16; }
                    if (PHON(13)) attn_item(P, L, sq, hh, qt, lam, lam_init, lds); }
            }
        } else if (sub == 4 && PHON(4)) {
            const bf16_t* YF = (const bf16_t*)(P.ws + WS_YF); const bf16_t* YB = (const bf16_t*)(P.ws + WS_YB); const bf16_t* xbc = (const bf16_t*)(P.ws + WS_XBC);
            const bf16_t* proj = (const bf16_t*)(P.ws + WS_PROJ); bf16_t* mix = (bf16_t*)(P.ws + WS_MIX);
            for (int m2 = gw; m2 < T / 2; m2 += NGW) { const int m = 2 * m2;
                float y[24]; float ss0 = 0.f, ss1 = 0.f;
#pragma unroll
                for (int j = 0; j < 3; ++j) { const int f = (j * 64 + lane) * 8, rw = f >= SSD_W ? 1 : 0, c0 = f - rw * SSD_W; const size_t row = (size_t)(m + rw);
                    const u32x4 a = *(const u32x4*)(YF + row * SSD_W + c0), b = *(const u32x4*)(YB + row * SSD_W + c0), x = *(const u32x4*)(xbc + row * XBC_W + c0), z = *(const u32x4*)(proj + row * PROJ_PITCH + ZOFF + c0);
                    const float dsk = P.in[I_SSDD][L * 12 + c0 / 64];
                    float fa[8], fb[8], fx[8], fz[8]; unpack8(a, fa); unpack8(b, fb); unpack8(x, fx); unpack8(z, fz); float sq = 0.f;
#pragma unroll
                    for (int k = 0; k < 8; ++k) { const float v = (fa[k] + fb[k] + dsk * fx[k]) * siluf_(fz[k]); y[j * 8 + k] = v; sq += v * v; }
                    if (rw) ss1 += sq; else ss0 += sq; }
                const float r0 = rsqrtf(wave_sum(ss0) * (1.f / SSD_W) + EPS), r1 = rsqrtf(wave_sum(ss1) * (1.f / SSD_W) + EPS);
#pragma unroll
                for (int j = 0; j < 3; ++j) { const int f = (j * 64 + lane) * 8, rw = f >= SSD_W ? 1 : 0, c0 = f - rw * SSD_W; const float rstd = rw ? r1 : r0;
                    const f32x4 g0 = *(const f32x4*)(P.in[I_SSDNG] + L * SSD_W + c0), g1 = *(const f32x4*)(P.in[I_SSDNG] + L * SSD_W + c0 + 4);
                    u32x4 w; w.x = cvtpk(y[j * 8] * rstd * g0.x, y[j * 8 + 1] * rstd * g0.y); w.y = cvtpk(y[j * 8 + 2] * rstd * g0.z, y[j * 8 + 3] * rstd * g0.w);
                    w.z = cvtpk(y[j * 8 + 4] * rstd * g1.x, y[j * 8 + 5] * rstd * g1.y); w.w = cvtpk(y[j * 8 + 6] * rstd * g1.z, y[j * 8 + 7] * rstd * g1.w);
                    *(u32x4*)(mix + (size_t)(m + rw) * DM + 512 + c0) = w; }
            }
        } else if (sub == 99 && PHON(11)) {
            for (int m = gw; m < T; m += NGW) final_row((const bf16_t*)(P.ws + WS_HB) + (size_t)m * DM, P.out + (size_t)m * DM, P.in[I_FNG], RSS[5 * T + m], lane);
        }
        if (ph + 1 < P0.ph_hi && sub != 8) xcd_barrier(xbar);
    }
}

extern "C" void kernel_launch(void* const* d_in, const int* in_sizes, int n_in, void* d_out, int out_size, void* d_ws, size_t ws_size, hipStream_t stream) {
    static int grid = 0;
    if (grid == 0) {
        if (n_in != 30 || out_size != T * DM || ws_size < WS_END) { fprintf(stderr, "kernel_launch: unexpected shapes (n_in %d out %d ws %zu)\n", n_in, out_size, ws_size); grid = -1; return; }
        int dev = 0, cus = 0, per_cu = 0;
        hipGetDevice(&dev); hipDeviceGetAttribute(&cus, hipDeviceAttributeMultiprocessorCount, dev);
        if (hipFuncSetAttribute((const void*)hybrid_fwd, hipFuncAttributeMaxDynamicSharedMemorySize, LDS_BYTES) != hipSuccess) { fprintf(stderr, "kernel_launch: hipFuncSetAttribute failed\n"); grid = -1; return; }
        hipOccupancyMaxActiveBlocksPerMultiprocessor(&per_cu, (const void*)hybrid_fwd, 512, LDS_BYTES);
        (void)hipGetLastError();
        if (per_cu < 1) fprintf(stderr, "kernel_launch: occupancy query says %d blocks per CU\n", per_cu);
        grid = cus > 0 ? cus : 256;
    }
    if (grid < 0) return;
    Params p{};
    for (int i = 0; i < 30; ++i) p.in[i] = (const float*)d_in[i];
    p.out = (float*)d_out; p.ws = (unsigned char*)d_ws;
#if MK_MULTI
    for (int ph = 0; ph < NPHASES; ++ph) { p.ph_lo = ph; p.ph_hi = ph + 1; hipLaunchKernelGGL(hybrid_fwd, dim3(grid), dim3(512), LDS_BYTES, stream, p); }
#else
    p.ph_lo = 0; p.ph_hi = NPHASES;
    void* args[] = {&p};
    hipError_t e = hipLaunchCooperativeKernel((const void*)hybrid_fwd, dim3(grid), dim3(512), args, LDS_BYTES, stream);
    if (e != hipSuccess) fprintf(stderr, "kernel_launch: cooperative launch failed: %s (grid %d)\n", hipGetErrorString(e), grid);
#endif
}
```

```cpp
#include <hip/hip_runtime.h>
#include <hip/hip_cooperative_groups.h>
#include <cstdio>
#include <cstdint>
#include <cmath>
namespace cg = cooperative_groups;

#ifndef MK_MULTI
#define MK_MULTI 0
#endif

#ifndef PROBE_SUB
#define PROBE_SUB -1
#endif
#ifndef PHMASK
#define PHMASK 0xFFFFu
#endif
#define PHON(n) (((PHMASK) >> (n)) & 1u)
#define LAS __attribute__((address_space(3)))
typedef unsigned short bf16_t;
typedef short bf16x8 __attribute__((ext_vector_type(8)));
typedef short s16x4 __attribute__((ext_vector_type(4)));
typedef float f32x4 __attribute__((ext_vector_type(4)));
typedef float f32x2 __attribute__((ext_vector_type(2)));
typedef float f32x16 __attribute__((ext_vector_type(16)));
typedef unsigned u32x4 __attribute__((ext_vector_type(4)));
typedef unsigned u32x2 __attribute__((ext_vector_type(2)));
typedef __bf16 bf16x2_t __attribute__((ext_vector_type(2)));

constexpr int DM = 2048, TP = 4 * 2048, TS = 8 * 4096, T = TP + TS;
constexpr int IN_COLS = 5400, PROJ_PITCH = 5632, DFF = 8192, PLE = 256;
constexpr int ZOFF = 1024, XBCOFF = 1792, QOFF = 3072, KOFF = 3840, VOFF = 4608, DTOFF = 5376;
constexpr int XBC_W = 1280, SSD_W = 768;
constexpr float EPS = 1e-6f, LOG2E = 1.4426950408889634f;
constexpr size_t MiB = 1u << 20;
constexpr size_t WS_CTL = 0, WS_DT = 1 * MiB, WS_WIN = 6 * MiB, WS_WOUT = 28 * MiB, WS_WUP = 36 * MiB, WS_WDN = 68 * MiB, WS_WG = 100 * MiB, WS_WPLE = 108 * MiB;
constexpr size_t WS_U = 110 * MiB, WS_YF = 110 * MiB, WS_YB = 170 * MiB;
constexpr size_t WS_X = 270 * MiB, WS_PROJ = 270 * MiB, WS_MIX = 710 * MiB, WS_HID = 270 * MiB, WS_PE = 270 * MiB;
constexpr size_t WS_E = 910 * MiB, WS_XBC = 910 * MiB, WS_PB = 910 * MiB, WS_RSS = 1010 * MiB, WS_END = 1014 * MiB;
typedef unsigned long long u64_t;
constexpr float RSS_SCALE = 1048576.f, RSS_INV = 1.f / (1048576.f * 2048.f);
constexpr size_t WS_HB = 110 * MiB, WS_HB2 = 710 * MiB;
constexpr int LDS_BYTES = 147456;
constexpr int NSUB = 10, NPH_LAYER = NSUB + (PROBE_SUB >= 0 ? 1 : 0), NPHASES = 2 * NPH_LAYER + 1;

__device__ __forceinline__ float bf2f(unsigned v) { return __uint_as_float(v << 16); }
__device__ __forceinline__ unsigned cvtpk(float lo, float hi) { f32x2 v = {lo, hi}; bf16x2_t b = __builtin_convertvector(v, bf16x2_t); return __builtin_bit_cast(unsigned, b); }
__device__ __forceinline__ bf16_t f2bf(float f) { return (bf16_t)(cvtpk(f, 0.f) & 0xffffu); }
__device__ __forceinline__ void unpack8(const u32x4 w, float (&f)[8]) {
#pragma unroll
    for (int k = 0; k < 4; ++k) { f[2 * k] = __uint_as_float(w[k] << 16); f[2 * k + 1] = __uint_as_float(w[k] & 0xffff0000u); }
}
__device__ __forceinline__ float wave_sum(float v) {
#pragma unroll
    for (int o = 1; o < 64; o <<= 1) v += __shfl_xor(v, o);
    return v;
}
__device__ __forceinline__ int opaque_tid() { int t = threadIdx.x; asm volatile("" : "+v"(t)); return t; }
__device__ __forceinline__ float sigmoidf_(float x) { return 1.f / (1.f + __expf(-x)); }
__device__ __forceinline__ float siluf_(float x) { return x / (1.f + __expf(-x)); }

namespace pg8 {
constexpr int BM = 256, BK = 64, HALF = 128, HTB = HALF * BK * 2, STAGE_BYTES = 8 * HTB, NXCD = 8, WGM = 8;
__host__ __device__ __forceinline__ int lds_byte(int r, int c) { const int st = (r >> 4) * 2 + (c >> 5), rr = r & 15, cc = c & 31, ob = rr * 64 + cc * 2; return st * 1024 + (ob ^ (((ob >> 9) & 1) << 5)); }
__host__ __device__ __forceinline__ void stage_rc(int b, int& R, int& C) { const int st = b / 1024, sb = b % 1024, swz = sb ^ (((sb >> 9) & 1) << 5); R = (st >> 1) * 16 + swz / 64; C = (st & 1) * 32 + (swz % 64) / 2; }
__host__ __device__ __forceinline__ int perm32(int rho) { const int n = rho >> 4, i = rho & 15; return 8 * (i >> 2) + 4 * n + (i & 3); }
struct Unit { int pm, pn; };
struct Gemm { const bf16_t* A; const bf16_t* Bt; int M, N, K; };
struct StaticOrder {
    int nM, nN, nwg, G, c;
    __host__ __device__ void init(int M, int N, int G_, int c_) { nM = M / BM; nN = N / BM; nwg = nM * nN; G = G_; c = c_; }
    __host__ __device__ bool next(int i, Unit& u) const {
        const long L = (long)i * G + c; if (L >= nwg) return false;
        int wgid = (int)L; { const int q = nwg / NXCD, r = nwg % NXCD, xcd = wgid % NXCD, off = wgid / NXCD; wgid = (xcd < r ? xcd * (q + 1) : r * (q + 1) + (xcd - r) * q) + off; }
        const int nig = WGM * nN, gid = wgid / nig, fm = gid * WGM, gsz = (nM - fm) < WGM ? (nM - fm) : WGM;
        u.pm = fm + ((wgid % nig) % gsz); u.pn = (wgid % nig) / gsz; return true;
    }
};
template <class Epi>
__device__ __forceinline__ void gemm_phase(LAS unsigned char* lds, const Gemm g, const StaticOrder& S, const Epi& E) {
    const int tid = opaque_tid(), wid = __builtin_amdgcn_readfirstlane(tid >> 6), lane = tid & 63, wr = wid >> 2, wc = wid & 3, fr = lane & 15, fq = lane >> 4;
    const int K = g.K, nt = K / BK;
    unsigned voffA[2], voffB[2];
#pragma unroll
    for (int i = 0; i < 2; ++i) { int R, C; stage_rc(tid * 16 + i * 8192, R, C); const int Rb = E.perm ? ((R & ~31) + perm32(R & 31)) : R;
        voffA[i] = (unsigned)(R * K + C) * 2u; voffB[i] = (unsigned)(Rb * K + C) * 2u; }
    const size_t kstep = (size_t)(BK * 2);
    const size_t hstep = (size_t)HALF * K * 2;
    const size_t tstep = 2 * hstep;
    const unsigned ldsw = (unsigned)wid * 1024u;
    const int aoff = lds_byte(wr * 64 + fr, fq * 8), boff = lds_byte(wc * 32 + fr, fq * 8);
#define PG8_SA(b, h) (((b) * 2 + (h)) * HTB)
#define PG8_SB(b, h) ((4 + (b) * 2 + (h)) * HTB)
#define PG8_STAGE(bufoff, gbase, voff) do { _Pragma("unroll") for (int _i = 0; _i < 2; ++_i) \
        __builtin_amdgcn_global_load_lds((const unsigned*)((const char*)(gbase) + (voff)[_i]), (LAS unsigned*)(lds + (bufoff) + ldsw + _i * 8192), 16, 0, 0); } while (0)
#define PG8_LDA(dst, b, h) do { _Pragma("unroll") for (int m = 0; m < 4; ++m) _Pragma("unroll") for (int k = 0; k < 2; ++k) dst[m][k] = *(const LAS bf16x8*)(lds + PG8_SA(b, h) + aoff + m * 2048 + k * 1024); } while (0)
#define PG8_LDB(dst, b, h) do { _Pragma("unroll") for (int n = 0; n < 2; ++n) _Pragma("unroll") for (int k = 0; k < 2; ++k) dst[n][k] = *(const LAS bf16x8*)(lds + PG8_SB(b, h) + boff + n * 2048 + k * 1024); } while (0)
#define PG8_MMA(ai, bj, At, Bt) do { __builtin_amdgcn_s_setprio(1); _Pragma("unroll") for (int m = 0; m < 4; ++m) _Pragma("unroll") for (int n = 0; n < 2; ++n) _Pragma("unroll") for (int k = 0; k < 2; ++k) \
        acc[ai][bj][m][n] = __builtin_amdgcn_mfma_f32_16x16x32_bf16(Bt[n][k], At[m][k], acc[ai][bj][m][n], 0, 0, 0); __builtin_amdgcn_s_setprio(0); } while (0)
#define PG8_WAIT_V(n) asm volatile("s_waitcnt vmcnt(" #n ")" ::: "memory")
#define PG8_WAIT_L(n) asm volatile("s_waitcnt lgkmcnt(" #n ")" ::: "memory")
#define PG8_BAR __builtin_amdgcn_s_barrier()
#define PG8_SCHED __builtin_amdgcn_sched_barrier(0)
    Unit cur, nxt; int ui = 0;
    if (!S.next(0, cur)) return;
    f32x4 acc[2][2][4][2];
#pragma unroll
    for (int a = 0; a < 2; ++a)
#pragma unroll
        for (int b = 0; b < 2; ++b)
#pragma unroll
            for (int m = 0; m < 4; ++m)
#pragma unroll
                for (int n = 0; n < 2; ++n) acc[a][b][m][n] = (f32x4){0.f, 0.f, 0.f, 0.f};
    bf16x8 At[4][2], B0[2][2], B1[2][2];
    const char* cA = (const char*)g.A + (size_t)cur.pm * tstep; const char* cB = (const char*)g.Bt + (size_t)cur.pn * tstep;
    PG8_STAGE(PG8_SB(0, 0), cB, voffB); PG8_STAGE(PG8_SB(0, 1), cB + hstep, voffB); PG8_STAGE(PG8_SA(0, 0), cA, voffA); PG8_STAGE(PG8_SA(0, 1), cA + hstep, voffA);
    if (wr == 1) PG8_BAR;
    PG8_WAIT_V(2); PG8_BAR;
    PG8_STAGE(PG8_SB(1, 0), cB + kstep, voffB); PG8_STAGE(PG8_SA(1, 0), cA + kstep, voffA); PG8_STAGE(PG8_SB(1, 1), cB + hstep + kstep, voffB);
    PG8_WAIT_V(6); PG8_BAR;
    for (;;) {
        const bool has_next = S.next(ui + 1, nxt);
        const char* nA = has_next ? (const char*)g.A + (size_t)nxt.pm * tstep : cA; const char* nB = has_next ? (const char*)g.Bt + (size_t)nxt.pn * tstep : cB;
        for (int t = 0; t < nt; t += 2) {
            const bool last = (t == nt - 2);
            const char* a1 = cA + (size_t)(t + 1) * kstep;
            const char* a2 = last ? nA : cA + (size_t)(t + 2) * kstep; const char* b2 = last ? nB : cB + (size_t)(t + 2) * kstep;
            const char* a3 = a2 + kstep; const char* b3 = b2 + kstep;
            PG8_LDB(B0, 0, 0); PG8_LDB(B1, 0, 1); PG8_SCHED; PG8_LDA(At, 0, 0); PG8_STAGE(PG8_SA(1, 1), a1 + hstep, voffA);
            PG8_WAIT_V(8); PG8_WAIT_L(0); PG8_BAR; PG8_MMA(0, 0, At, B0); PG8_MMA(0, 1, At, B1); PG8_BAR; PG8_SCHED;
            PG8_LDA(At, 0, 1); PG8_STAGE(PG8_SB(0, 0), b2, voffB); PG8_STAGE(PG8_SB(0, 1), b2 + hstep, voffB); PG8_STAGE(PG8_SA(0, 0), a2, voffA);
            PG8_WAIT_V(8); PG8_WAIT_L(0); PG8_BAR; PG8_MMA(1, 0, At, B0); PG8_MMA(1, 1, At, B1); PG8_BAR; PG8_SCHED;
            PG8_LDB(B0, 1, 0); PG8_LDB(B1, 1, 1); PG8_SCHED; PG8_LDA(At, 1, 0); PG8_STAGE(PG8_SA(0, 1), a2 + hstep, voffA);
            PG8_WAIT_V(8); PG8_WAIT_L(0); PG8_BAR; PG8_MMA(0, 0, At, B0); PG8_MMA(0, 1, At, B1); PG8_BAR; PG8_SCHED;
            PG8_LDA(At, 1, 1); PG8_STAGE(PG8_SB(1, 0), b3, voffB); PG8_STAGE(PG8_SB(1, 1), b3 + hstep, voffB); PG8_STAGE(PG8_SA(1, 0), a3, voffA);
            PG8_WAIT_V(8); PG8_WAIT_L(0); PG8_BAR; PG8_MMA(1, 0, At, B0); PG8_MMA(1, 1, At, B1); PG8_BAR; PG8_SCHED;
        }
        if (wr == 0) PG8_BAR;
        E(acc, cur, wr, wc, fr, fq);
        if (!has_next) break;
#pragma unroll
        for (int a = 0; a < 2; ++a)
#pragma unroll
            for (int b = 0; b < 2; ++b)
#pragma unroll
                for (int m = 0; m < 4; ++m)
#pragma unroll
                    for (int n = 0; n < 2; ++n) acc[a][b][m][n] = (f32x4){0.f, 0.f, 0.f, 0.f};
        cur = nxt; cA = nA; cB = nB; ++ui;
        if (wr == 1) PG8_BAR;
    }
    PG8_WAIT_V(0);
    PG8_BAR;
#undef PG8_SA
#undef PG8_SB
#undef PG8_STAGE
#undef PG8_LDA
#undef PG8_LDB
#undef PG8_MMA
#undef PG8_WAIT_V
#undef PG8_WAIT_L
#undef PG8_BAR
#undef PG8_SCHED
}

typedef const f32x4 (&AccRef)[2][2][4][2];
struct EpiAny { int kind; bool perm; bf16_t* O; int ldc; const bf16_t* Hs; float* dt; const bf16_t* PE; bf16_t* HB; const u64_t* rin; u64_t* rout;
    __device__ __forceinline__ void operator()(AccRef acc, const Unit& u, int wr, int wc, int fr, int fq) const {
        const int row0 = u.pm * BM + wr * 64 + fr, col0 = u.pn * BM + wc * 32 + 8 * fq;
        if (kind == 1 || kind == 4) {
#pragma unroll
            for (int ai = 0; ai < 2; ++ai) {
                u32x4 hw[4][2], pw[4][2]; float rsv[4];
#pragma unroll
                for (int m = 0; m < 4; ++m) { const int row = row0 + ai * HALF + m * 16; const size_t ro = (size_t)row * DM + col0;
                    rsv[m] = 1.f; if (kind == 4) rsv[m] = (float)rin[row];
#pragma unroll
                    for (int bj = 0; bj < 2; ++bj) { hw[m][bj] = *(const u32x4*)(Hs + ro + bj * HALF); if (kind == 4) pw[m][bj] = *(const u32x4*)(PE + ro + bj * HALF); else pw[m][bj] = (u32x4){0u, 0u, 0u, 0u}; } }
#pragma unroll
                for (int m = 0; m < 4; ++m) { const int row = row0 + ai * HALF + m * 16; const size_t ro = (size_t)row * DM + col0; float ssq = 0.f;
                    float rs = 1.f; if (kind == 4) rs = rsqrtf(rsv[m] * RSS_INV + EPS);
#pragma unroll
                    for (int bj = 0; bj < 2; ++bj) { f32x4 v0 = acc[ai][bj][m][0], v1 = acc[ai][bj][m][1];
                        float hf[8]; unpack8(hw[m][bj], hf);
                        if (kind == 4) { float pe[8]; unpack8(pw[m][bj], pe);
#pragma unroll
                            for (int j = 0; j < 4; ++j) { v0[j] = pe[j] * sigmoidf_(v0[j] * rs); v1[j] = pe[4 + j] * sigmoidf_(v1[j] * rs); } }
#pragma unroll
                        for (int j = 0; j < 4; ++j) { v0[j] += hf[j]; v1[j] += hf[4 + j]; }
                        ssq += (v0.x * v0.x + v0.y * v0.y) + (v0.z * v0.z + v0.w * v0.w) + (v1.x * v1.x + v1.y * v1.y) + (v1.z * v1.z + v1.w * v1.w);
                        u32x4 w; w.x = cvtpk(v0[0], v0[1]); w.y = cvtpk(v0[2], v0[3]); w.z = cvtpk(v1[0], v1[1]); w.w = cvtpk(v1[2], v1[3]);
                        *(u32x4*)(HB + ro + bj * HALF) = w; }
                    ssq += __shfl_xor(ssq, 16); ssq += __shfl_xor(ssq, 32);
                    if (fq == 0) atomicAdd(rout + row, (u64_t)(ssq * RSS_SCALE)); }
                asm volatile("" ::: "memory"); }
        } else {
            const bool sq = (kind == 2), nrm = (kind != 3);
#pragma unroll
            for (int ai = 0; ai < 2; ++ai)
#pragma unroll
                for (int m = 0; m < 4; ++m) { const int row = row0 + ai * HALF + m * 16; bf16_t* rowp = O + (size_t)row * ldc + col0;
                    float rs = 1.f; if (nrm) rs = rsqrtf((float)rin[row] * RSS_INV + EPS);
#pragma unroll
                    for (int bj = 0; bj < 2; ++bj) { f32x4 v0 = acc[ai][bj][m][0] * rs, v1 = acc[ai][bj][m][1] * rs;
                        if (sq) {
#pragma unroll
                            for (int j = 0; j < 4; ++j) { const float a = fmaxf(v0[j], 0.f), b = fmaxf(v1[j], 0.f); v0[j] = a * a; v1[j] = b * b; } }
                        u32x4 w; w.x = cvtpk(v0[0], v0[1]); w.y = cvtpk(v0[2], v0[3]); w.z = cvtpk(v1[0], v1[1]); w.w = cvtpk(v1[2], v1[3]);
                        *(u32x4*)(rowp + bj * HALF) = w; }
                    if (kind == 0 && u.pn == DTOFF / BM && wc == 0) { float* dp = dt + (size_t)row * 32 + 8 * fq; *(f32x4*)dp = acc[ai][0][m][0] * rs; *(f32x4*)(dp + 4) = acc[ai][0][m][1] * rs; } }
        }
    }
};
}

struct Params { const float* in[30]; float* out; unsigned char* ws; int ph_lo, ph_hi; };
typedef const __attribute__((address_space(4))) Params CP;
enum { I_XP = 0, I_XS, I_PP, I_PS, I_NMIXG, I_WIN, I_CONVW, I_CONVB, I_CNG, I_CNB, I_SCW, I_SCB, I_DTB, I_ALOG, I_SSDD, I_SSDNG, I_LQ1, I_LK1, I_LQ2, I_LK2, I_SUBLN, I_RELB, I_WOUT, I_NMLPG, I_WUP, I_WDN, I_NPLEG, I_WPLE, I_WG, I_FNG };

__device__ __forceinline__ void seq_of(int sq, int& start, int& len) { if (sq < 4) { start = sq * 2048; len = 2048; } else { start = TP + (sq - 4) * 4096; len = 4096; } }
__device__ __forceinline__ void seq_bounds_of_tok(int t, int& start, int& end) { if (t < TP) { start = t & ~2047; end = start + 2048; } else { start = TP + ((t - TP) & ~4095); end = start + 4096; } }

__device__ __forceinline__ int map_in_col(int nd) {
    if (nd < QOFF) return nd;
    if (nd < DTOFF) return nd + 24;
    if (nd < DTOFF + 24) return nd - DTOFF + QOFF;
    return -1;
}
template <bool MAPIN>
__device__ __forceinline__ void transpose_item(const float* W, const float* gk, int K, int Nsrc, int nblk, bf16_t* WT, LAS float* scr, int item, int lane) {
    const int kb = item / nblk, nb = item % nblk, k0 = 64 * kb, n0 = 32 * nb;
    const int nd = n0 + (lane & 31); const int ns = MAPIN ? map_in_col(nd) : nd;
#pragma unroll 8
    for (int i = 0; i < 32; ++i) { const int kk = 2 * i + (lane >> 5); const float gg = gk ? gk[k0 + kk] : 1.f; scr[kk * 33 + (lane & 31)] = (ns >= 0) ? W[(size_t)(k0 + kk) * Nsrc + ns] * gg : 0.f; }
    asm volatile("s_waitcnt lgkmcnt(0)" ::: "memory");
    const int c = lane & 7;
#pragma unroll
    for (int j = 0; j < 4; ++j) { const int n = (lane >> 3) + 8 * j; const LAS float* s = scr + (8 * c) * 33 + n;
        u32x4 o; o.x = cvtpk(s[0 * 33], s[1 * 33]); o.y = cvtpk(s[2 * 33], s[3 * 33]); o.z = cvtpk(s[4 * 33], s[5 * 33]); o.w = cvtpk(s[6 * 33], s[7 * 33]);
        *(u32x4*)(WT + (size_t)(n0 + n) * K + k0 + 8 * c) = o; }
    asm volatile("s_waitcnt lgkmcnt(0)" ::: "memory");
}
__device__ __forceinline__ void prep_row(const float* src, bf16_t* hb, u64_t* rss, int lane) {
    const f32x4* xr = (const f32x4*)src + lane; f32x4 v[8]; float s = 0.f;
#pragma unroll
    for (int j = 0; j < 8; ++j) { v[j] = xr[64 * j]; s += (v[j].x * v[j].x + v[j].y * v[j].y) + (v[j].z * v[j].z + v[j].w * v[j].w); }
    s = wave_sum(s);
#pragma unroll
    for (int j = 0; j < 8; ++j) { u32x2 w; w.x = cvtpk(v[j].x, v[j].y); w.y = cvtpk(v[j].z, v[j].w); ((u32x2*)hb + lane)[64 * j] = w; }
    if (lane == 0) *rss = (u64_t)(s * RSS_SCALE);
}
__device__ __forceinline__ void final_row(const bf16_t* h, float* out, const float* g, u64_t ss, int lane) {
    const float rstd = rsqrtf((float)ss * RSS_INV + EPS);
    const u32x2* hr = (const u32x2*)h + lane; f32x4* orow = (f32x4*)out + lane; const f32x4* gr = (const f32x4*)g + lane;
#pragma unroll
    for (int j = 0; j < 8; ++j) { const u32x2 w = hr[64 * j]; const f32x4 gg = gr[64 * j];
        f32x4 v; v.x = __uint_as_float(w.x << 16); v.y = __uint_as_float(w.x & 0xffff0000u); v.z = __uint_as_float(w.y << 16); v.w = __uint_as_float(w.y & 0xffff0000u);
        orow[64 * j] = v * rstd * gg; }
}

__device__ __forceinline__ void conv_module_item(CP& P, int L, int item, LAS unsigned char* lds) {
    const int tid = opaque_tid(), lane = tid & 63, wid = tid >> 6;
    const bf16_t* proj = (const bf16_t*)(P.ws + WS_PROJ); bf16_t* mix = (bf16_t*)(P.ws + WS_MIX);
    const int t0 = item * 32; int s0, s1; seq_bounds_of_tok(t0, s0, s1);
    LAS float* U = (LAS float*)lds;
#pragma unroll
    for (int i = 0; i < 8; ++i) { const int id = tid + 512 * i, rr = id >> 6, c8 = (id & 63) * 8; const int t = t0 - 15 + rr;
        if (rr < 62) { f32x4 u0 = {0.f, 0.f, 0.f, 0.f}, u1 = {0.f, 0.f, 0.f, 0.f};
            if (t >= s0 && t < s1) { const u32x4 vv = *(const u32x4*)(proj + (size_t)t * PROJ_PITCH + c8), gv = *(const u32x4*)(proj + (size_t)t * PROJ_PITCH + 512 + c8);
                float v[8], g[8]; unpack8(vv, v); unpack8(gv, g);
#pragma unroll
                for (int j = 0; j < 4; ++j) { u0[j] = v[j] * sigmoidf_(g[j]); u1[j] = v[4 + j] * sigmoidf_(g[4 + j]); } }
            *(LAS f32x4*)(U + rr * 512 + c8) = u0; *(LAS f32x4*)(U + rr * 512 + c8 + 4) = u1; } }
    float w[31];
#pragma unroll
    for (int j = 0; j < 31; ++j) w[j] = P.in[I_CONVW][(size_t)L * 31 * 512 + j * 512 + tid];
    const float cb = P.in[I_CONVB][L * 512 + tid];
    __syncthreads();
    float o[32];
    {   float u[62];
#pragma unroll
        for (int rr = 0; rr < 62; ++rr) u[rr] = U[rr * 512 + tid];
#pragma unroll
        for (int tt = 0; tt < 32; ++tt) { float a = cb;
#pragma unroll
            for (int j = 0; j < 31; ++j) a += u[tt + j] * w[j];
            o[tt] = a; } }
    __syncthreads();
#pragma unroll
    for (int tt = 0; tt < 32; ++tt) U[tt * 512 + tid] = o[tt];
    __syncthreads();
    const f32x4 g0 = *((const f32x4*)(P.in[I_CNG] + L * 512) + 2 * lane), g1 = *((const f32x4*)(P.in[I_CNG] + L * 512) + 2 * lane + 1);
    const f32x4 b0 = *((const f32x4*)(P.in[I_CNB] + L * 512) + 2 * lane), b1 = *((const f32x4*)(P.in[I_CNB] + L * 512) + 2 * lane + 1);
#pragma unroll
    for (int k = 0; k < 4; ++k) { const int tt = wid * 4 + k;
        const f32x4 x0 = *((const LAS f32x4*)(U + tt * 512) + 2 * lane), x1 = *((const LAS f32x4*)(U + tt * 512) + 2 * lane + 1);
        const float mu = wave_sum((x0.x + x0.y) + (x0.z + x0.w) + (x1.x + x1.y) + (x1.z + x1.w)) * (1.f / 512.f);
        const f32x4 d0 = x0 - mu, d1 = x1 - mu;
        const float var = wave_sum((d0.x * d0.x + d0.y * d0.y) + (d0.z * d0.z + d0.w * d0.w) + (d1.x * d1.x + d1.y * d1.y) + (d1.z * d1.z + d1.w * d1.w)) * (1.f / 512.f);
        const float rstd = rsqrtf(var + EPS);
        f32x4 y0 = d0 * rstd * g0 + b0, y1 = d1 * rstd * g1 + b1;
#pragma unroll
        for (int j = 0; j < 4; ++j) { y0[j] = siluf_(y0[j]); y1[j] = siluf_(y1[j]); }
        u32x4 wv; wv.x = cvtpk(y0[0], y0[1]); wv.y = cvtpk(y0[2], y0[3]); wv.z = cvtpk(y1[0], y1[1]); wv.w = cvtpk(y1[2], y1[3]);
        *(u32x4*)(mix + (size_t)(t0 + tt) * DM + 8 * lane) = wv; }
    __syncthreads();
}
__device__ __forceinline__ void xbc_conv_item(CP& P, int L, int item) {
    const int tid = opaque_tid(); const int cg = tid % 160, rs = tid / 160; const int seg = item * 3 + rs;
    if (rs >= 3 || seg >= T / 32) return;
    const bf16_t* proj = (const bf16_t*)(P.ws + WS_PROJ); bf16_t* xbc = (bf16_t*)(P.ws + WS_XBC);
    const int c8 = cg * 8, r0 = seg * 32; int s0, s1; seq_bounds_of_tok(r0, s0, s1);
    const float* cw = P.in[I_SCW] + (size_t)L * 5 * XBC_W + c8; const float* cbp = P.in[I_SCB] + L * XBC_W + c8;
    float w[5][8], bs[8];
#pragma unroll
    for (int j = 0; j < 5; ++j) { const f32x4 a = *(const f32x4*)(cw + j * XBC_W), b = *(const f32x4*)(cw + j * XBC_W + 4); w[j][0] = a.x; w[j][1] = a.y; w[j][2] = a.z; w[j][3] = a.w; w[j][4] = b.x; w[j][5] = b.y; w[j][6] = b.z; w[j][7] = b.w; }
    { const f32x4 a = *(const f32x4*)cbp, b = *(const f32x4*)(cbp + 4); bs[0] = a.x; bs[1] = a.y; bs[2] = a.z; bs[3] = a.w; bs[4] = b.x; bs[5] = b.y; bs[6] = b.z; bs[7] = b.w; }
    const bf16_t* src = proj + XBCOFF + c8;
    u32x4 win[5];
#pragma unroll
    for (int j = 0; j < 4; ++j) { const int t = r0 - 2 + j; win[j + 1] = (t >= s0 && t < s1) ? *(const u32x4*)(src + (size_t)t * PROJ_PITCH) : (u32x4){0u, 0u, 0u, 0u}; }
#pragma unroll 4
    for (int r = 0; r < 32; ++r) {
#pragma unroll
        for (int j = 0; j < 4; ++j) win[j] = win[j + 1];
        { const int t = r0 + r + 2; win[4] = (t >= s0 && t < s1) ? *(const u32x4*)(src + (size_t)t * PROJ_PITCH) : (u32x4){0u, 0u, 0u, 0u}; }
        float a[8];
#pragma unroll
        for (int k = 0; k < 8; ++k) a[k] = bs[k];
#pragma unroll
        for (int j = 0; j < 5; ++j) { float x[8]; unpack8(win[j], x);
#pragma unroll
            for (int k = 0; k < 8; ++k) a[k] += x[k] * w[j][k]; }
#pragma unroll
        for (int k = 0; k < 8; ++k) a[k] = siluf_(a[k]);
        u32x4 o; o.x = cvtpk(a[0], a[1]); o.y = cvtpk(a[2], a[3]); o.z = cvtpk(a[4], a[5]); o.w = cvtpk(a[6], a[7]);
        *(u32x4*)(xbc + (size_t)(r0 + r) * XBC_W + c8) = o;
    }
}

#define MFMA32(a, b, c) __builtin_amdgcn_mfma_f32_32x32x16_bf16((a), (b), (c), 0, 0, 0)
__device__ __forceinline__ int crow(int r, int hi) { return (r & 3) + 8 * (r >> 2) + 4 * hi; }
__device__ __forceinline__ bf16x8 pack_step(const f32x16& x, int s) {
    u32x4 p; p.x = cvtpk(x[8 * s], x[8 * s + 1]); p.y = cvtpk(x[8 * s + 2], x[8 * s + 3]); p.z = cvtpk(x[8 * s + 4], x[8 * s + 5]); p.w = cvtpk(x[8 * s + 6], x[8 * s + 7]);
    return __builtin_bit_cast(bf16x8, p);
}

typedef short v4i16s_t __attribute__((ext_vector_type(4)));
constexpr int SP = 272, SXP = 144;
constexpr int S_CM = 0, S_BM = 128 * SP, S_BD = 2 * 128 * SP, S_XD = 3 * 128 * SP, S_PV = S_XD + 128 * SXP, S_AS = S_PV + 64 * SP, S_DTV = S_AS + 132 * 4, S_END = S_DTV + 128 * 4;
static_assert(S_END <= LDS_BYTES - 64, "ssd lds");
__device__ __forceinline__ bf16x8 ssd_trfrag(const LAS unsigned char* p, int pitch) {
    const s16x4 lo = __builtin_bit_cast(s16x4, __builtin_amdgcn_ds_read_tr16_b64_v4i16((LAS v4i16s_t*)p));
    const s16x4 hi = __builtin_bit_cast(s16x4, __builtin_amdgcn_ds_read_tr16_b64_v4i16((LAS v4i16s_t*)(p + 4 * pitch)));
    return __builtin_shufflevector(lo, hi, 0, 1, 2, 3, 4, 5, 6, 7);
}
__device__ __forceinline__ void ssd_item(CP& P, int L, int sq, int hd, int dir, LAS unsigned char* lds) {
    const int tid = opaque_tid(), lane = tid & 63, wid = __builtin_amdgcn_readfirstlane(tid >> 6), r = lane & 31, hi = lane >> 5;
    int sstart, slen; seq_of(sq, sstart, slen); const int nc = slen / 128, g = hd / 6;
    const bf16_t* xbc = (const bf16_t*)(P.ws + WS_XBC); const float* DT = (const float*)(P.ws + WS_DT);
    bf16_t* Y = (bf16_t*)(P.ws + (dir ? WS_YB : WS_YF));
    const float Aneg = -__expf(P.in[I_ALOG][L * 24 + dir * 12 + hd]), dtb = P.in[I_DTB][L * 24 + dir * 12 + hd]; const int dcol = dir * 12 + hd;
    LAS float* AS = (LAS float*)(lds + S_AS); LAS float* DTV = (LAS float*)(lds + S_DTV);
    f32x16 st;
#pragma unroll
    for (int i = 0; i < 16; ++i) st[i] = 0.f;
    for (int i = tid; i < 64 * SP / 4; i += 512) ((LAS unsigned*)(lds + S_PV))[i] = 0u;
    const int crow_ = tid >> 4, cch = tid & 15;
    const int xrow_ = tid >> 3, xch = tid & 7;
    const int lb = wid >> 1, pb = wid & 1, nb = wid >> 1;
    const int trq = (lane & 15) >> 2, trb = ((lane >> 4) & 1) * 32 + (lane & 3) * 8;
    const int xdo = S_XD + (8 * hi + trq) * SXP + 64 * pb + trb;
    const int bdo = S_BD + (8 * hi + trq) * SP + 64 * nb + trb;
    u32x4 cv[4], bv[4], xv[2]; float r0 = 0.f, r1 = 0.f;
#define SSD_LOAD(tk) do { const bf16_t* rp_ = xbc + (size_t)(tk) * XBC_W; \
        _Pragma("unroll") for (int i = 0; i < 4; ++i) { cv[i] = *(const u32x4*)(rp_ + (size_t)(crow_ + 32 * i) * XBC_W + 1024 + g * 128 + cch * 8); bv[i] = *(const u32x4*)(rp_ + (size_t)(crow_ + 32 * i) * XBC_W + 768 + g * 128 + cch * 8); } \
        _Pragma("unroll") for (int i = 0; i < 2; ++i) xv[i] = *(const u32x4*)(rp_ + (size_t)(xrow_ + 64 * i) * XBC_W + hd * 64 + xch * 8); \
        if (wid == 0) { r0 = DT[(size_t)((tk) + lane) * 32 + dcol]; r1 = DT[(size_t)((tk) + 64 + lane) * 32 + dcol]; } } while (0)
    SSD_LOAD(sstart + (dir ? nc - 1 : 0) * 128);
    for (int ci = 0; ci < nc; ++ci) {
        const int c = dir ? nc - 1 - ci : ci; const int tok0 = sstart + c * 128;
        if (wid == 0) {
            const float q0 = r0 + dtb, q1 = r1 + dtb;
            const float d0 = q0 > 20.f ? q0 : log1pf(__expf(q0)), d1 = q1 > 20.f ? q1 : log1pf(__expf(q1));
            const float x0 = d0 * Aneg, x1 = d1 * Aneg; float p0 = x0, p1 = x1;
#pragma unroll
            for (int o = 1; o < 64; o <<= 1) { const float t0 = __shfl_up(p0, o), t1 = __shfl_up(p1, o); if (lane >= o) { p0 += t0; p1 += t1; } }
            const float tot0 = __shfl(p0, 63), tot1 = __shfl(p1, 63); p1 += tot0; const float total = tot0 + tot1;
            float a0 = p0, a1 = p1; if (dir) { a0 = total - p0 + x0; a1 = total - p1 + x1; }
            AS[lane] = a0; AS[64 + lane] = a1; DTV[lane] = d0; DTV[64 + lane] = d1; if (lane == 0) AS[128] = total;
        }
        __syncthreads();
        { const float aend = AS[128];
#pragma unroll
          for (int i = 0; i < 4; ++i) { const int row = crow_ + 32 * i; const float dec = __expf(aend - AS[row]);
              *(LAS u32x4*)(lds + S_CM + row * SP + cch * 16) = cv[i]; *(LAS u32x4*)(lds + S_BM + row * SP + cch * 16) = bv[i];
              float f[8]; unpack8(bv[i], f); u32x4 w; w.x = cvtpk(f[0] * dec, f[1] * dec); w.y = cvtpk(f[2] * dec, f[3] * dec); w.z = cvtpk(f[4] * dec, f[5] * dec); w.w = cvtpk(f[6] * dec, f[7] * dec);
              *(LAS u32x4*)(lds + S_BD + row * SP + cch * 16) = w; }
#pragma unroll
          for (int i = 0; i < 2; ++i) { const int row = xrow_ + 64 * i; const float dtv = DTV[row]; float f[8]; unpack8(xv[i], f);
              u32x4 w; w.x = cvtpk(f[0] * dtv, f[1] * dtv); w.y = cvtpk(f[2] * dtv, f[3] * dtv); w.z = cvtpk(f[4] * dtv, f[5] * dtv); w.w = cvtpk(f[6] * dtv, f[7] * dtv);
              *(LAS u32x4*)(lds + S_XD + row * SXP + xch * 16) = w; } }
        if (ci + 1 < nc) SSD_LOAD(sstart + (dir ? nc - 2 - ci : ci + 1) * 128);
        __syncthreads();
        {   const int lrow = 32 * lb + r; const float a_l = AS[lrow];
            f32x16 yd, yo;
#pragma unroll
            for (int i = 0; i < 16; ++i) { yd[i] = 0.f; yo[i] = 0.f; }
            const int sb0 = dir ? lb : 0, sb1 = dir ? 4 : lb + 1;
#pragma unroll
            for (int sb = 0; sb < 4; ++sb) if (sb >= sb0 && sb < sb1) {
                f32x16 cb;
#pragma unroll
                for (int i = 0; i < 16; ++i) cb[i] = 0.f;
#pragma unroll
                for (int ks = 0; ks < 8; ++ks) { const bf16x8 av = *(const LAS bf16x8*)(lds + S_BM + (32 * sb + r) * SP + (16 * ks + 8 * hi) * 2);
                    const bf16x8 bv2 = *(const LAS bf16x8*)(lds + S_CM + lrow * SP + (16 * ks + 8 * hi) * 2); cb = MFMA32(av, bv2, cb); }
#pragma unroll
                for (int i = 0; i < 16; ++i) { const int sr = 32 * sb + crow(i, hi); const bool ok = dir ? (sr >= lrow) : (sr <= lrow); const float gv = cb[i] * __expf(a_l - AS[sr]); cb[i] = ok ? gv : 0.f; }
#pragma unroll
                for (int s2 = 0; s2 < 2; ++s2) { const LAS unsigned char* xp = lds + S_XD + (32 * sb + 16 * s2 + 4 * hi + trq) * SXP + 64 * pb + trb;
                    const s16x4 lo = __builtin_bit_cast(s16x4, __builtin_amdgcn_ds_read_tr16_b64_v4i16((LAS v4i16s_t*)xp));
                    const s16x4 hi4 = __builtin_bit_cast(s16x4, __builtin_amdgcn_ds_read_tr16_b64_v4i16((LAS v4i16s_t*)(xp + 8 * SXP)));
                    const bf16x8 xa = __builtin_shufflevector(lo, hi4, 0, 1, 2, 3, 4, 5, 6, 7);
                    yd = MFMA32(xa, pack_step(cb, s2), yd); }
            }
#pragma unroll
            for (int ks = 0; ks < 8; ++ks) { const bf16x8 av = *(const LAS bf16x8*)(lds + S_PV + (32 * pb + r) * SP + (16 * ks + 8 * hi) * 2);
                const bf16x8 bv2 = *(const LAS bf16x8*)(lds + S_CM + lrow * SP + (16 * ks + 8 * hi) * 2); yo = MFMA32(av, bv2, yo); }
            const float el = __expf(a_l);
            bf16_t* yp = Y + (size_t)(tok0 + lrow) * SSD_W + hd * 64 + 32 * pb + 4 * hi;
#pragma unroll
            for (int g4 = 0; g4 < 4; ++g4) { u32x2 w; w.x = cvtpk(yd[4 * g4] + el * yo[4 * g4], yd[4 * g4 + 1] + el * yo[4 * g4 + 1]); w.y = cvtpk(yd[4 * g4 + 2] + el * yo[4 * g4 + 2], yd[4 * g4 + 3] + el * yo[4 * g4 + 3]);
                *(u32x2*)(yp + 8 * g4) = w; }
            const float cd = __expf(AS[128]);
#pragma unroll
            for (int i = 0; i < 16; ++i) st[i] *= cd;
#pragma unroll
            for (int ks = 0; ks < 8; ++ks) { const bf16x8 xa = ssd_trfrag(lds + xdo + 16 * ks * SXP, SXP); const bf16x8 bb = ssd_trfrag(lds + bdo + 16 * ks * SP, SP); st = MFMA32(xa, bb, st); }
        }
        __syncthreads();
#pragma unroll
        for (int i = 0; i < 16; ++i) *(LAS bf16_t*)(lds + S_PV + (32 * pb + crow(i, hi)) * SP + (32 * nb + r) * 2) = f2bf(st[i]);
    }
    __syncthreads();
#undef SSD_LOAD
}

typedef short v4i16_t __attribute__((ext_vector_type(4)));
constexpr int A_SLOT = 32768, A_VI = 16384, A_NSLOT = 4, A_TBL = A_NSLOT * A_SLOT, A_O2P = 132;
static_assert(A_TBL + 260 * 4 <= LDS_BYTES - 64 && 128 * A_O2P * 4 <= A_TBL, "attn lds");
__device__ __forceinline__ void attn_item(CP& P, int L, int sq, int hh, int qt, float lam, float lam_init, LAS unsigned char* lds) {
    const int tid = opaque_tid(), lane = tid & 63, wid = __builtin_amdgcn_readfirstlane(tid >> 6), r = lane & 31, hi = lane >> 5, map = wid >> 2, wq = wid & 3;
    int sstart, slen; seq_of(sq, sstart, slen); const int ntiles = slen / 64;
    const bf16_t* proj = (const bf16_t*)(P.ws + WS_PROJ); bf16_t* mix = (bf16_t*)(P.ws + WS_MIX);
    LAS float* tbl = (LAS float*)(lds + A_TBL);
    if (tid < 257) { const int rel = tid - 128; const int n = rel < 0 ? -rel : rel; int bk;
        if (n < 8) bk = n; else { int k = (31 - __builtin_clz((unsigned)(n * n))) - 6; bk = 8 + k; if (bk > 15) bk = 15; }
        if (rel > 0) bk += 16;
        tbl[tid] = P.in[I_RELB][bk * 6 + hh] * LOG2E; }
    const int qpos = qt * 128 + wq * 32 + r;
    const float SC = 0.125f * LOG2E;
    bf16x8 qf[4];
    { const bf16_t* qp = proj + (size_t)(sstart + qpos) * PROJ_PITCH + QOFF + hh * 128 + map * 64 + hi * 8;
#pragma unroll
      for (int s = 0; s < 4; ++s) { const u32x4 w = *(const u32x4*)(qp + 16 * s); float f[8]; unpack8(w, f); u32x4 o4;
          o4.x = cvtpk(f[0] * SC, f[1] * SC); o4.y = cvtpk(f[2] * SC, f[3] * SC); o4.z = cvtpk(f[4] * SC, f[5] * SC); o4.w = cvtpk(f[6] * SC, f[7] * SC); qf[s] = __builtin_bit_cast(bf16x8, o4); } }
    f32x16 o[4];
#pragma unroll
    for (int c = 0; c < 4; ++c)
#pragma unroll
        for (int i = 0; i < 16; ++i) o[c][i] = 0.f;
    float mref = 0.f, lrun = 0.f;
    const bf16_t* gk[2]; const bf16_t* gv[2];
#pragma unroll
    for (int i = 0; i < 2; ++i) { const int n = 2 * wid + i;
        { const int rr = 8 * (n & 7) + (lane >> 3), c = (lane & 7) ^ ((rr >> 1) & 7); gk[i] = proj + (size_t)(sstart + rr) * PROJ_PITCH + KOFF + hh * 128 + (n >> 3) * 64 + c * 8; }
        { const int rr = 4 * n + (lane >> 4), ch = (lane & 15) ^ (4 * (rr & 3)); gv[i] = proj + (size_t)(sstart + rr) * PROJ_PITCH + VOFF + hh * 128 + ch * 8; } }
#define ATT_DMA(t, slot) do { const size_t to_ = (size_t)(t) * 64 * PROJ_PITCH; LAS unsigned char* sd_ = lds + (slot) * A_SLOT + wid * 2048; \
        _Pragma("unroll") for (int i = 0; i < 2; ++i) { \
            __builtin_amdgcn_global_load_lds((const unsigned*)(gk[i] + to_), (LAS unsigned*)(sd_ + i * 1024), 16, 0, 0); \
            __builtin_amdgcn_global_load_lds((const unsigned*)(gv[i] + to_), (LAS unsigned*)(sd_ + A_VI + i * 1024), 16, 0, 0); } } while (0)
#define ATT_WAITBAR(N) do { asm volatile("s_waitcnt vmcnt(" #N ") lgkmcnt(0)" ::: "memory"); __builtin_amdgcn_s_barrier(); asm volatile("" ::: "memory"); } while (0)
    const int q0w = qt * 128 + wq * 32;
    const int m7 = (r >> 1) & 7;
    const int kfo = map * 8192 + r * 128;
    int kso[4];
#pragma unroll
    for (int s = 0; s < 4; ++s) kso[s] = ((2 * s + hi) ^ m7) * 16;
    const int vq = (lane & 15) >> 2;
    const int vfo = A_VI + (4 * hi + vq) * 256 + ((lane >> 4) & 1) * 32 + (lane & 3) * 8;
    bf16x8 pf[2][2];
    f32x16 p[2];
#define SB() __builtin_amdgcn_sched_barrier(0)
#define ATT_KRD(sbuf) do { const unsigned ka_ = (unsigned)(size_t)(lds + (sbuf) * A_SLOT + kfo); \
        _Pragma("unroll") for (int s_ = 0; s_ < 4; ++s_) { const unsigned kas_ = ka_ + (unsigned)kso[s_]; \
            asm volatile("ds_read_b128 %0, %1" : "=&v"(kf[s_]) : "v"(kas_) : "memory"); \
            asm volatile("ds_read_b128 %0, %1 offset:4096" : "=&v"(kf[4 + s_]) : "v"(kas_) : "memory"); } } while (0)
#define ATT_QKM(t) do { _Pragma("unroll") for (int kb = 0; kb < 2; ++kb) _Pragma("unroll") for (int i = 0; i < 16; ++i) p[kb][i] = cinit_; \
        SB(); __builtin_amdgcn_s_setprio(1); \
        _Pragma("unroll") for (int s_ = 0; s_ < 4; ++s_) _Pragma("unroll") for (int kb = 0; kb < 2; ++kb) p[kb] = MFMA32(kf[kb * 4 + s_], qf[s_], p[kb]); \
        __builtin_amdgcn_s_setprio(0); SB(); } while (0)
#define ATT_TR(dst, addr, off) asm volatile("ds_read_b64_tr_b16 %0, %1 offset:%c2" : "=&v"(dst) : "v"(addr), "i"(off) : "memory")
#define ATT_LWAIT() asm volatile("s_waitcnt lgkmcnt(0)" ::: "memory")
#define ATT_VRD(dst, c) do { const unsigned va_ = vaddr_ + 64u * (unsigned)((c) ^ vq); \
        ATT_TR(dst[0], va_, 0);     ATT_TR(dst[1], va_, 2048);  ATT_TR(dst[2], va_, 4096);  ATT_TR(dst[3], va_, 6144); \
        ATT_TR(dst[4], va_, 8192);  ATT_TR(dst[5], va_, 10240); ATT_TR(dst[6], va_, 12288); ATT_TR(dst[7], va_, 14336); } while (0)
#define ATT_VMM(src, c) do { __builtin_amdgcn_s_setprio(1); _Pragma("unroll") for (int kb = 0; kb < 2; ++kb) _Pragma("unroll") for (int s_ = 0; s_ < 2; ++s_) { \
            const bf16x8 vb_ = __builtin_shufflevector(src[2 * (kb * 2 + s_)], src[2 * (kb * 2 + s_) + 1], 0, 1, 2, 3, 4, 5, 6, 7); \
            o[c] = MFMA32(vb_, pf[kb][s_], o[c]); } __builtin_amdgcn_s_setprio(0); } while (0)
#define ATT_VMM2(srca, ca, srcb, cb) do { __builtin_amdgcn_s_setprio(1); _Pragma("unroll") for (int kb = 0; kb < 2; ++kb) _Pragma("unroll") for (int s_ = 0; s_ < 2; ++s_) { \
            const bf16x8 va_ = __builtin_shufflevector(srca[2 * (kb * 2 + s_)], srca[2 * (kb * 2 + s_) + 1], 0, 1, 2, 3, 4, 5, 6, 7); \
            const bf16x8 vb_ = __builtin_shufflevector(srcb[2 * (kb * 2 + s_)], srcb[2 * (kb * 2 + s_) + 1], 0, 1, 2, 3, 4, 5, 6, 7); \
            o[ca] = MFMA32(va_, pf[kb][s_], o[ca]); o[cb] = MFMA32(vb_, pf[kb][s_], o[cb]); } __builtin_amdgcn_s_setprio(0); } while (0)
#define ATT_PV(sbuf) do { const unsigned vaddr_ = (unsigned)(size_t)(lds + (sbuf) * A_SLOT + vfo); s16x4 va0_[8], va1_[8]; \
        ATT_VRD(va0_, 0); ATT_VRD(va1_, 1); ATT_LWAIT(); SB(); ATT_VMM2(va0_, 0, va1_, 1); SB(); \
        ATT_VRD(va0_, 2); ATT_VRD(va1_, 3); ATT_LWAIT(); SB(); ATT_VMM2(va0_, 2, va1_, 3); SB(); } while (0)
#define ATT_SOFTMAX(t) do { const int k0_ = (t) * 64; \
        if (!far_) { _Pragma("unroll") for (int kb = 0; kb < 2; ++kb) _Pragma("unroll") for (int i = 0; i < 16; ++i) { \
            int rel_ = k0_ + kb * 32 + crow(i, hi) - qpos; rel_ = rel_ < -128 ? -128 : (rel_ > 128 ? 128 : rel_); p[kb][i] += tbl[rel_ + 128]; } } \
        float mx_; bool resc_; \
        if ((t) == 0) { mx_ = fmaxf(p[0][0], p[1][0]); _Pragma("unroll") for (int i = 1; i < 16; ++i) mx_ = fmaxf(mx_, fmaxf(p[0][i], p[1][i])); mx_ = fmaxf(mx_, __shfl_xor(mx_, 32)); resc_ = true; } \
        else { int im_ = __float_as_int(p[0][0]);   \
            _Pragma("unroll") for (int i = 0; i < 16; ++i) { const int a_ = __float_as_int(p[0][i]), b_ = __float_as_int(p[1][i]); im_ = (im_ > a_ ? im_ : a_); im_ = (im_ > b_ ? im_ : b_); } \
            const int io_ = __shfl_xor(im_, 32); im_ = im_ > io_ ? im_ : io_; mx_ = __int_as_float(im_); resc_ = __any(im_ > 0x41000000); } \
        if (resc_) { \
            const float dl_ = ((t) == 0) ? mx_ : (mx_ > 0.f ? mx_ : 0.f); mref += dl_; const float f_ = __builtin_amdgcn_exp2f(-dl_); lrun *= f_; \
            _Pragma("unroll") for (int kb = 0; kb < 2; ++kb) _Pragma("unroll") for (int i = 0; i < 16; ++i) p[kb][i] -= dl_; \
            _Pragma("unroll") for (int c = 0; c < 4; ++c) _Pragma("unroll") for (int i = 0; i < 16; ++i) o[c][i] *= f_; } \
        f32x2 ls_ = {0.f, 0.f}; \
        _Pragma("unroll") for (int i = 0; i < 16; ++i) { f32x2 e_; e_.x = __builtin_amdgcn_exp2f(p[0][i]); e_.y = __builtin_amdgcn_exp2f(p[1][i]); p[0][i] = e_.x; p[1][i] = e_.y; ls_ += e_; } \
        lrun += ls_.x + ls_.y; \
        _Pragma("unroll") for (int kb = 0; kb < 2; ++kb) _Pragma("unroll") for (int s_ = 0; s_ < 2; ++s_) pf[kb][s_] = pack_step(p[kb], s_); } while (0)
    bool far_ = false;
    ATT_DMA(0, 0); ATT_DMA((1 < ntiles ? 1 : ntiles - 1), 1);
    ATT_WAITBAR(4);
    bf16x8 kf[8];
    for (int t = 0; t < ntiles; ++t) {
        { const int tn = (t + 2 < ntiles) ? t + 2 : ntiles - 1; ATT_DMA(tn, (t + 2) & 3); }
        const int k0_ = t * 64; const bool farR_ = (k0_ - (q0w + 31) >= 128), farL_ = (q0w - (k0_ + 63) >= 128); far_ = farR_ || farL_;
        const float cinit_ = (far_ ? (farR_ ? tbl[256] : tbl[0]) : 0.f) - mref;
        if (t > 0) {
            const unsigned vaddr_ = (unsigned)(size_t)(lds + ((t - 1) & 3) * A_SLOT + vfo); s16x4 va0_[8], va1_[8];
            ATT_VRD(va0_, 0); ATT_VRD(va1_, 1); ATT_LWAIT(); SB();
            ATT_VMM2(va0_, 0, va1_, 1); SB();
            ATT_VRD(va0_, 2); ATT_VRD(va1_, 3); ATT_LWAIT(); ATT_KRD(t & 3); SB();
            ATT_VMM2(va0_, 2, va1_, 3); SB(); ATT_LWAIT(); SB();
        } else { ATT_KRD(0); ATT_LWAIT(); SB(); }
        ATT_QKM(t);
        ATT_SOFTMAX(t);
        ATT_WAITBAR(4);
    }
    ATT_PV((ntiles - 1) & 3);
    __builtin_amdgcn_s_setprio(0);
    asm volatile("s_waitcnt vmcnt(0)" ::: "memory");
    __syncthreads();
#undef ATT_DMA
#undef ATT_WAITBAR
#undef ATT_KRD
#undef ATT_QKM
#undef ATT_PV
#undef ATT_VRD
#undef ATT_VMM
#undef ATT_VMM2
#undef ATT_TR
#undef ATT_LWAIT
#undef ATT_SOFTMAX
#undef SB
    lrun += __shfl_xor(lrun, 32);
    const float inv = 1.f / lrun;
    LAS float* O2 = (LAS float*)lds;
    if (map == 1) {
#pragma unroll
        for (int c = 0; c < 4; ++c)
#pragma unroll
            for (int i = 0; i < 16; ++i) O2[(wq * 32 + r) * A_O2P + 32 * c + crow(i, hi)] = o[c][i] * inv;
    }
    __syncthreads();
    if (map == 0) {
        float ss = 0.f;
#pragma unroll
        for (int c = 0; c < 4; ++c)
#pragma unroll
            for (int i = 0; i < 16; ++i) { const float v = o[c][i] * inv - lam * O2[(wq * 32 + r) * A_O2P + 32 * c + crow(i, hi)]; o[c][i] = v; ss += v * v; }
        ss += __shfl_xor(ss, 32);
        const float rstd = rsqrtf(ss * (1.f / 128.f) + EPS) * (1.f - lam_init);
        const float* sg = P.in[I_SUBLN] + L * 128;
        bf16_t* op = mix + (size_t)(sstart + qpos) * DM + 1280 + hh * 128;
#pragma unroll
        for (int c = 0; c < 4; ++c)
#pragma unroll
            for (int gq = 0; gq < 4; ++gq) { const int dv = 32 * c + 8 * gq + 4 * hi; const f32x4 gg = *(const f32x4*)(sg + dv);
                u32x2 w; w.x = cvtpk(o[c][4 * gq] * rstd * gg.x, o[c][4 * gq + 1] * rstd * gg.y); w.y = cvtpk(o[c][4 * gq + 2] * rstd * gg.z, o[c][4 * gq + 3] * rstd * gg.w);
                *(u32x2*)(op + dv) = w; }
    }
    __syncthreads();
}

#define XB_TMO      128
#define XB_XCNT(j)  (256  + 64 * (j))
#define XB_XSUB(j)  (1280 + 64 * (j))
#define XB_XGEN(j)  (2304 + 64 * (j))
#define XB_TOP      3328
#define XB_TOPGEN   3392
#define XCD_BAR_WORDS 3456
#define XB_SPIN_CAP (1u << 18)
__device__ __forceinline__ unsigned xb_ld(unsigned* p)              { return __hip_atomic_load(p, __ATOMIC_RELAXED, __HIP_MEMORY_SCOPE_AGENT); }
__device__ __forceinline__ unsigned xb_add(unsigned* p, unsigned v) { return __hip_atomic_fetch_add(p, v, __ATOMIC_RELAXED, __HIP_MEMORY_SCOPE_AGENT); }
__device__ __forceinline__ unsigned xb_xcc_id() { return (unsigned)__builtin_amdgcn_s_getreg((3 << 11) | 20) & 0xFu; }
#define XB_SPIN(cond, bar) do { unsigned _sp = 0; while (cond) { __builtin_amdgcn_s_sleep(1); \
    if ((++_sp & 255u) == 0u) { if (xb_ld(&(bar)[XB_TMO])) break; if (_sp > XB_SPIN_CAP) { atomicAdd(&(bar)[XB_TMO], 1u); break; } } } } while (0)
struct XcdBarrier { unsigned* bar; unsigned x; volatile LAS unsigned* st; };
__device__ __forceinline__ XcdBarrier xcd_barrier_post(unsigned* bar, volatile LAS unsigned* st) {
    XcdBarrier b; b.bar = bar; b.x = xb_xcc_id(); b.st = st;
    if (threadIdx.x == 0) (void)xb_add(&bar[XB_XCNT(b.x)], 1u);
    return b;
}
__device__ __forceinline__ void xcd_barrier_complete(unsigned* bar, unsigned x, unsigned& nloc, unsigned& nx) {
    const unsigned G = gridDim.x * gridDim.y * gridDim.z;
    unsigned sum, cnt, mine, sp = 0u;
    for (;;) {
        sum = 0u; cnt = 0u; mine = 0u;
#pragma unroll
        for (unsigned j = 0; j < 16; ++j) { const unsigned c = xb_ld(&bar[XB_XCNT(j)]); sum += c; cnt += (c > 0u) ? 1u : 0u; mine = (j == x) ? c : mine; }
        if (sum == G) break;
        __builtin_amdgcn_s_sleep(1);
        if ((++sp & 255u) == 0u) { if (xb_ld(&bar[XB_TMO])) break; if (sp > XB_SPIN_CAP) { atomicAdd(&bar[XB_TMO], 1u); break; } }
    }
    nloc = mine > 0u ? mine : 1u; nx = cnt > 0u ? cnt : 1u;
}
__device__ __forceinline__ void xcd_barrier(const XcdBarrier& b) {
    asm volatile("s_waitcnt vmcnt(0)" ::: "memory");
    __syncthreads();
    if (threadIdx.x == 0) {
        unsigned* bar = b.bar;
        __builtin_amdgcn_s_waitcnt(0);
        unsigned nloc = b.st[0], nx = b.st[1];
        if (nloc == 0u) { xcd_barrier_complete(bar, b.x, nloc, nx); b.st[0] = nloc; b.st[1] = nx; }
        const unsigned old = xb_add(&bar[XB_XSUB(b.x)], 1u);
        const unsigned gen = old / nloc;
        if (old + 1u == (gen + 1u) * nloc) {
            __builtin_amdgcn_fence(__ATOMIC_RELEASE, "agent");
            asm volatile("s_waitcnt vmcnt(0)" ::: "memory");
            const unsigned og = xb_add(&bar[XB_TOP], 1u);
            const unsigned tg = og / nx;
            if (og + 1u == (tg + 1u) * nx) xb_add(&bar[XB_TOPGEN], 1u);
            else XB_SPIN(xb_ld(&bar[XB_TOPGEN]) == tg, bar);
            __builtin_amdgcn_fence(__ATOMIC_ACQUIRE, "agent");
            xb_add(&bar[XB_XGEN(b.x)], 1u);
            asm volatile("s_waitcnt vmcnt(0)" ::: "memory");
        } else {
            XB_SPIN(xb_ld(&bar[XB_XGEN(b.x)]) == gen, bar);
            __builtin_amdgcn_fence(__ATOMIC_ACQUIRE, "agent");
            asm volatile("s_waitcnt vmcnt(0)" ::: "memory");
        }
    }
    __syncthreads();
}

__global__ void __launch_bounds__(512, 2) hybrid_fwd(Params P0) {
    extern __shared__ __attribute__((aligned(16))) unsigned char lds_raw[];
    LAS unsigned char* lds = (LAS unsigned char*)lds_raw;
    cg::grid_group grid = cg::this_grid();
    const int G = gridDim.x, bx = blockIdx.x, NGW = G * 8;
    XcdBarrier xbar; xbar.bar = nullptr; xbar.x = 0; xbar.st = nullptr;
    if (P0.ph_hi - P0.ph_lo > 1) {
        unsigned* bw = (unsigned*)(P0.ws + WS_CTL) + 4096;
        volatile LAS unsigned* st = (volatile LAS unsigned*)(lds + LDS_BYTES - 32);
        if (threadIdx.x == 0) { st[0] = 0u; st[1] = 0u; }
        __syncthreads();
        if (P0.ph_lo < 0) grid.sync();
        xbar = xcd_barrier_post(bw, st);
    }
    for (int ph = P0.ph_lo; ph < P0.ph_hi; ++ph) {
        const int L = ph / NPH_LAYER; int sub = ph % NPH_LAYER; int rep = 0; if (PROBE_SUB >= 0 && sub > PROBE_SUB) { rep = (sub == PROBE_SUB + 1); --sub; } if (ph == NPHASES - 1) sub = 99;
        const int tid = opaque_tid(), lane = tid & 63, wid = __builtin_amdgcn_readfirstlane(tid >> 6), gw = bx * 8 + wid;
        CP* pp = (CP*)__builtin_amdgcn_kernarg_segment_ptr(); asm volatile("" : "+s"(pp)); CP& P = *pp;
        unsigned* ctl = (unsigned*)(P.ws + WS_CTL); u64_t* RSS = (u64_t*)(P.ws + WS_RSS);
        bf16_t* Hin = (bf16_t*)P.out + (L == 0 ? (size_t)0 : (size_t)T * DM); bf16_t* Hout = (L == 0) ? (bf16_t*)P.out + (size_t)T * DM : (bf16_t*)(P.ws + WS_HB);
        if (sub == 0 && PHON(0)) {
            if (bx == 0 && tid == 0) {
                ctl[64 + 2 * L] = 0u; ctl[64 + 2 * L + 1] = 0u;
                float s1 = 0.f, s2 = 0.f;
                for (int i = 0; i < 64; ++i) { s1 += P.in[I_LQ1][L * 64 + i] * P.in[I_LK1][L * 64 + i]; s2 += P.in[I_LQ2][L * 64 + i] * P.in[I_LK2][L * 64 + i]; }
                const float lam_init = 0.8f - 0.6f * expf(-0.3f * (float)L);
                ((float*)ctl)[128 + L] = expf(s1) - expf(s2) + lam_init;
            }
            LAS float* scr = (LAS float*)(lds + wid * 16384);
            constexpr int I_IN = 32 * 176, I_OUT = 32 * 64, I_UP = 32 * 256, I_DN = 128 * 64, I_GT = 32 * 64, I_PL = 4 * 64, NIT = I_IN + I_OUT + I_UP + I_DN + I_GT + I_PL;
            for (int it = gw; it < NIT; it += NGW) { int q = it;
                if (q < I_IN) { transpose_item<true>(P.in[I_WIN] + (size_t)L * DM * IN_COLS, P.in[I_NMIXG] + L * DM, DM, IN_COLS, 176, (bf16_t*)(P.ws + WS_WIN), scr, q, lane); continue; } q -= I_IN;
                if (q < I_OUT) { transpose_item<false>(P.in[I_WOUT] + (size_t)L * DM * DM, nullptr, DM, DM, 64, (bf16_t*)(P.ws + WS_WOUT), scr, q, lane); continue; } q -= I_OUT;
                if (q < I_UP) { transpose_item<false>(P.in[I_WUP] + (size_t)L * DM * DFF, P.in[I_NMLPG] + L * DM, DM, DFF, 256, (bf16_t*)(P.ws + WS_WUP), scr, q, lane); continue; } q -= I_UP;
                if (q < I_DN) { transpose_item<false>(P.in[I_WDN] + (size_t)L * DFF * DM, nullptr, DFF, DM, 64, (bf16_t*)(P.ws + WS_WDN), scr, q, lane); continue; } q -= I_DN;
                if (q < I_GT) { transpose_item<false>(P.in[I_WG] + (size_t)L * DM * DM, P.in[I_NPLEG] + L * DM, DM, DM, 64, (bf16_t*)(P.ws + WS_WG), scr, q, lane); continue; } q -= I_GT;
                transpose_item<false>(P.in[I_WPLE] + (size_t)L * PLE * DM, nullptr, PLE, DM, 64, (bf16_t*)(P.ws + WS_WPLE), scr, q, lane);
            }
            if (L == 0) {
                { const int nth = G * 512, nit = (6 * T + nth - 1) / nth; for (int k = 0; k < nit; ++k) { const int i = k * nth + bx * 512 + tid; if (i < 6 * T) RSS[i] = 0ull; } }
                for (int m = gw; m < T; m += NGW) {
                    const float* src = (m < TP) ? P.in[I_XP] + (size_t)m * DM : P.in[I_XS] + (size_t)(m - TP) * DM;
                    prep_row(src, Hin + (size_t)m * DM, RSS + 6 * T + m, lane);
                }
            }
        } else if ((sub == 1 || sub == 5 || sub == 6 || sub == 7 || sub == 8 || sub == 9) && PHON(1)) {
            if (sub == 7) {
                bf16_t* PB = (bf16_t*)(P.ws + WS_PB);
                for (int m = gw; m < T; m += NGW) {
                    const float* pr = (m < TP) ? P.in[I_PP] + ((size_t)L * TP + m) * PLE : P.in[I_PS] + ((size_t)L * TS + (m - TP)) * PLE;
                    const f32x4 v = *((const f32x4*)pr + lane); u32x2 w; w.x = cvtpk(v.x, v.y); w.y = cvtpk(v.z, v.w); *((u32x2*)(PB + (size_t)m * PLE) + lane) = w; }
            }
            pg8::Gemm g; pg8::EpiAny E; E.O = nullptr; E.ldc = DM; E.Hs = Hin; E.dt = (float*)(P.ws + WS_DT); E.PE = (const bf16_t*)(P.ws + WS_PE); E.perm = true; g.M = T;
            E.HB = Hin; E.rin = RSS; E.rout = RSS;
            const bf16_t* HBp = Hin;
            if (sub == 1)      { g.A = HBp; g.Bt = (const bf16_t*)(P.ws + WS_WIN); g.N = PROJ_PITCH; g.K = DM; E.kind = 0; E.O = (bf16_t*)(P.ws + WS_PROJ); E.ldc = PROJ_PITCH; E.rin = RSS + (L == 0 ? 6 : 2) * T; }
            else if (sub == 5) { g.A = (const bf16_t*)(P.ws + WS_MIX); g.Bt = (const bf16_t*)(P.ws + WS_WOUT); g.N = DM; g.K = DM; E.kind = 1; E.rout = RSS + (3 * L + 0) * T; }
            else if (sub == 6) { g.A = HBp; g.Bt = (const bf16_t*)(P.ws + WS_WUP); g.N = DFF; g.K = DM; E.kind = 2; E.O = (bf16_t*)(P.ws + WS_HID); E.ldc = DFF; E.rin = RSS + (3 * L + 0) * T; }
            else if (sub == 7) { g.A = (const bf16_t*)(P.ws + WS_HID); g.Bt = (const bf16_t*)(P.ws + WS_WDN); g.N = DM; g.K = DFF; E.kind = 1; E.rout = RSS + (3 * L + 1) * T; }
            else if (sub == 8) { g.A = (const bf16_t*)(P.ws + WS_PB); g.Bt = (const bf16_t*)(P.ws + WS_WPLE); g.N = DM; g.K = PLE; E.kind = 3; E.O = (bf16_t*)(P.ws + WS_PE); E.ldc = DM; }
            else               { g.A = HBp; g.Bt = (const bf16_t*)(P.ws + WS_WG); g.N = DM; g.K = DM; E.kind = 4; E.rin = RSS + (3 * L + 1) * T; E.rout = RSS + (3 * L + 2) * T; E.HB = Hout; }
            pg8::StaticOrder S; S.init(T, g.N, G, bx);
            pg8::gemm_phase<pg8::EpiAny>(lds, g, S, E);
            asm volatile("s_waitcnt vmcnt(0)" ::: "memory");
        } else if (sub == 2 && PHON(2)) {
            for (int it = bx; it < (T / 32 + 2) / 3; it += G) xbc_conv_item(P, L, it);
            for (int it = bx; it < T / 32; it += G) conv_module_item(P, L, it, lds);
        } else if (sub == 3 && PHON(3)) {
            const float lam = __uint_as_float(__hip_atomic_load(ctl + 128 + L, __ATOMIC_RELAXED, __HIP_MEMORY_SCOPE_AGENT)); const float lam_init = 0.8f - 0.6f * expf(-0.3f * (float)L);
            LAS int* qslot = (LAS int*)(lds + LDS_BYTES - 16);
            for (;;) {
                if (tid == 0) *qslot = (int)atomicAdd(&ctl[64 + 2 * L + rep], 1u);
                __syncthreads();
                const int item = *qslot;
                __syncthreads();
                if (item >= 288 + 1920) break;
                if (item < 288) { int sq, rem; if (item < 192) { sq = 4 + item / 24; rem = item % 24; } else { sq = (item - 192) / 24; rem = (item - 192) % 24; }
                    if (PHON(12)) ssd_item(P, L, sq, rem % 12, rem / 12, lds);
                } else { int sq, hh, qt;
                    if (item < 288 + 1536) { const int j = item - 288; sq = 4 + j / 192; hh = (j % 192) / 32; qt = j % 32; }
                    else { const int j = item - 288 - 1536; sq = j / 96; hh = (j % 96) / 16; qt = j % 16; }
                    if (PHON(13)) attn_item(P, L, sq, hh, qt, lam, lam_init, lds); }
            }
        } else if (sub == 4 && PHON(4)) {
            const bf16_t* YF = (const bf16_t*)(P.ws + WS_YF); const bf16_t* YB = (const bf16_t*)(P.ws + WS_YB); const bf16_t* xbc = (const bf16_t*)(P.ws + WS_XBC);
            const bf16_t* proj = (const bf16_t*)(P.ws + WS_PROJ); bf16_t* mix = (bf16_t*)(P.ws + WS_MIX);
            for (int m2 = gw; m2 < T / 2; m2 += NGW) { const int m = 2 * m2;
                float y[24]; float ss0 = 0.f, ss1 = 0.f;
#pragma unroll
                for (int j = 0; j < 3; ++j) { const int f = (j * 64 + lane) * 8, rw = f >= SSD_W ? 1 : 0, c0 = f - rw * SSD_W; const size_t row = (size_t)(m + rw);
                    const u32x4 a = *(const u32x4*)(YF + row * SSD_W + c0), b = *(const u32x4*)(YB + row * SSD_W + c0), x = *(const u32x4*)(xbc + row * XBC_W + c0), z = *(const u32x4*)(proj + row * PROJ_PITCH + ZOFF + c0);
                    const float dsk = P.in[I_SSDD][L * 12 + c0 / 64];
                    float fa[8], fb[8], fx[8], fz[8]; unpack8(a, fa); unpack8(b, fb); unpack8(x, fx); unpack8(z, fz); float sq = 0.f;
#pragma unroll
                    for (int k = 0; k < 8; ++k) { const float v = (fa[k] + fb[k] + dsk * fx[k]) * siluf_(fz[k]); y[j * 8 + k] = v; sq += v * v; }
                    if (rw) ss1 += sq; else ss0 += sq; }
                const float r0 = rsqrtf(wave_sum(ss0) * (1.f / SSD_W) + EPS), r1 = rsqrtf(wave_sum(ss1) * (1.f / SSD_W) + EPS);
#pragma unroll
                for (int j = 0; j < 3; ++j) { const int f = (j * 64 + lane) * 8, rw = f >= SSD_W ? 1 : 0, c0 = f - rw * SSD_W; const float rstd = rw ? r1 : r0;
                    const f32x4 g0 = *(const f32x4*)(P.in[I_SSDNG] + L * SSD_W + c0), g1 = *(const f32x4*)(P.in[I_SSDNG] + L * SSD_W + c0 + 4);
                    u32x4 w; w.x = cvtpk(y[j * 8] * rstd * g0.x, y[j * 8 + 1] * rstd * g0.y); w.y = cvtpk(y[j * 8 + 2] * rstd * g0.z, y[j * 8 + 3] * rstd * g0.w);
                    w.z = cvtpk(y[j * 8 + 4] * rstd * g1.x, y[j * 8 + 5] * rstd * g1.y); w.w = cvtpk(y[j * 8 + 6] * rstd * g1.z, y[j * 8 + 7] * rstd * g1.w);
                    *(u32x4*)(mix + (size_t)(m + rw) * DM + 512 + c0) = w; }
            }
        } else if (sub == 99 && PHON(11)) {
            for (int m = gw; m < T; m += NGW) final_row((const bf16_t*)(P.ws + WS_HB) + (size_t)m * DM, P.out + (size_t)m * DM, P.in[I_FNG], RSS[5 * T + m], lane);
        }
        if (ph + 1 < P0.ph_hi && sub != 8) xcd_barrier(xbar);
    }
}

extern "C" void kernel_launch(void* const* d_in, const int* in_sizes, int n_in, void* d_out, int out_size, void* d_ws, size_t ws_size, hipStream_t stream) {
    static int grid = 0;
    if (grid == 0) {
        if (n_in != 30 || out_size != T * DM || ws_size < WS_END) { fprintf(stderr, "kernel_launch: unexpected shapes (n_in %d out %d ws %zu)\n", n_in, out_size, ws_size); grid = -1; return; }
        int dev = 0, cus = 0, per_cu = 0;
        hipGetDevice(&dev); hipDeviceGetAttribute(&cus, hipDeviceAttributeMultiprocessorCount, dev);
        if (hipFuncSetAttribute((const void*)hybrid_fwd, hipFuncAttributeMaxDynamicSharedMemorySize, LDS_BYTES) != hipSuccess) { fprintf(stderr, "kernel_launch: hipFuncSetAttribute failed\n"); grid = -1; return; }
        hipOccupancyMaxActiveBlocksPerMultiprocessor(&per_cu, (const void*)hybrid_fwd, 512, LDS_BYTES);
        (void)hipGetLastError();
        if (per_cu < 1) fprintf(stderr, "kernel_launch: occupancy query says %d blocks per CU\n", per_cu);
        grid = cus > 0 ? cus : 256;
    }
    if (grid < 0) return;
    Params p{};
    for (int i = 0; i < 30; ++i) p.in[i] = (const float*)d_in[i];
    p.out = (float*)d_out; p.ws = (unsigned char*)d_ws;
#if MK_MULTI
    for (int ph = 0; ph < NPHASES; ++ph) { p.ph_lo = ph; p.ph_hi = ph + 1; hipLaunchKernelGGL(hybrid_fwd, dim3(grid), dim3(512), LDS_BYTES, stream, p); }
#else
    p.ph_lo = 0; p.ph_hi = NPHASES;
    (void)hipMemsetAsync((unsigned char*)d_ws + WS_CTL + 4096 * 4, 0, XCD_BAR_WORDS * 4, stream);
    void* args[] = {&p};
    hipError_t e = hipLaunchCooperativeKernel((const void*)hybrid_fwd, dim3(grid), dim3(512), args, LDS_BYTES, stream);
    if (e != hipSuccess) fprintf(stderr, "kernel_launch: cooperative launch failed: %s (grid %d)\n", hipGetErrorString(e), grid);
#endif
}
```

```cpp
#include <hip/hip_runtime.h>
#include <hip/hip_cooperative_groups.h>
#include <cstdio>
#include <cstdint>
#include <cmath>
namespace cg = cooperative_groups;

#ifndef MK_MULTI
#define MK_MULTI 0
#endif

#ifndef PROBE_SUB
#define PROBE_SUB -1
#endif
#ifndef PHMASK
#define PHMASK 0xFFFFu
#endif
#define PHON(n) (((PHMASK) >> (n)) & 1u)
#define LAS __attribute__((address_space(3)))
typedef unsigned short bf16_t;
typedef short bf16x8 __attribute__((ext_vector_type(8)));
typedef short s16x4 __attribute__((ext_vector_type(4)));
typedef float f32x4 __attribute__((ext_vector_type(4)));
typedef float f32x2 __attribute__((ext_vector_type(2)));
typedef float f32x16 __attribute__((ext_vector_type(16)));
typedef unsigned u32x4 __attribute__((ext_vector_type(4)));
typedef unsigned u32x2 __attribute__((ext_vector_type(2)));
typedef __bf16 bf16x2_t __attribute__((ext_vector_type(2)));

constexpr int DM = 2048, TP = 4 * 2048, TS = 8 * 4096, T = TP + TS;
constexpr int IN_COLS = 5400, PROJ_PITCH = 5632, DFF = 8192, PLE = 256;
constexpr int ZOFF = 1024, XBCOFF = 1792, QOFF = 3072, KOFF = 3840, VOFF = 4608, DTOFF = 5376;
constexpr int XBC_W = 1280, SSD_W = 768;
constexpr float EPS = 1e-6f, LOG2E = 1.4426950408889634f;
constexpr size_t MiB = 1u << 20;
constexpr size_t WS_CTL = 0, WS_DT = 1 * MiB, WS_WIN = 6 * MiB, WS_WOUT = 28 * MiB, WS_WUP = 36 * MiB, WS_WDN = 68 * MiB, WS_WG = 100 * MiB, WS_WPLE = 108 * MiB;
constexpr size_t WS_U = 110 * MiB, WS_YF = 110 * MiB, WS_YB = 170 * MiB;
constexpr size_t WS_X = 270 * MiB, WS_PROJ = 270 * MiB, WS_MIX = 710 * MiB, WS_HID = 270 * MiB, WS_PE = 270 * MiB;
constexpr size_t WS_E = 910 * MiB, WS_XBC = 910 * MiB, WS_PB = 910 * MiB, WS_RSS = 1010 * MiB, WS_END = 1014 * MiB;
typedef unsigned long long u64_t;
constexpr float RSS_SCALE = 1048576.f, RSS_INV = 1.f / (1048576.f * 2048.f);
constexpr size_t WS_HB = 110 * MiB, WS_HB2 = 710 * MiB;
constexpr int LDS_BYTES = 147456;
constexpr int NSUB = 10, NPH_LAYER = NSUB + (PROBE_SUB >= 0 ? 1 : 0), NPHASES = 2 * NPH_LAYER + 1;

__device__ __forceinline__ float bf2f(unsigned v) { return __uint_as_float(v << 16); }
__device__ __forceinline__ unsigned cvtpk(float lo, float hi) { f32x2 v = {lo, hi}; bf16x2_t b = __builtin_convertvector(v, bf16x2_t); return __builtin_bit_cast(unsigned, b); }
__device__ __forceinline__ bf16_t f2bf(float f) { return (bf16_t)(cvtpk(f, 0.f) & 0xffffu); }
__device__ __forceinline__ void unpack8(const u32x4 w, float (&f)[8]) {
#pragma unroll
    for (int k = 0; k < 4; ++k) { f[2 * k] = __uint_as_float(w[k] << 16); f[2 * k + 1] = __uint_as_float(w[k] & 0xffff0000u); }
}
__device__ __forceinline__ float wave_sum(float v) {
#pragma unroll
    for (int o = 1; o < 64; o <<= 1) v += __shfl_xor(v, o);
    return v;
}
__device__ __forceinline__ int opaque_tid() { int t = threadIdx.x; asm volatile("" : "+v"(t)); return t; }
__device__ __forceinline__ float sigmoidf_(float x) { return __builtin_amdgcn_rcpf(1.f + __builtin_amdgcn_exp2f(x * -LOG2E)); }
__device__ __forceinline__ float siluf_(float x) { return x * __builtin_amdgcn_rcpf(1.f + __builtin_amdgcn_exp2f(x * -LOG2E)); }

namespace pg8 {
constexpr int BM = 256, BK = 64, HALF = 128, HTB = HALF * BK * 2, STAGE_BYTES = 8 * HTB, NXCD = 8, WGM = 8;
__host__ __device__ __forceinline__ int lds_byte(int r, int c) { const int st = (r >> 4) * 2 + (c >> 5), rr = r & 15, cc = c & 31, ob = rr * 64 + cc * 2; return st * 1024 + (ob ^ (((ob >> 9) & 1) << 5)); }
__host__ __device__ __forceinline__ void stage_rc(int b, int& R, int& C) { const int st = b / 1024, sb = b % 1024, swz = sb ^ (((sb >> 9) & 1) << 5); R = (st >> 1) * 16 + swz / 64; C = (st & 1) * 32 + (swz % 64) / 2; }
__host__ __device__ __forceinline__ int perm32(int rho) { const int n = rho >> 4, i = rho & 15; return 8 * (i >> 2) + 4 * n + (i & 3); }
struct Unit { int pm, pn; };
struct Gemm { const bf16_t* A; const bf16_t* Bt; int M, N, K; };
struct StaticOrder {
    int nM, nN, nwg, G, c;
    __host__ __device__ void init(int M, int N, int G_, int c_) { nM = M / BM; nN = N / BM; nwg = nM * nN; G = G_; c = c_; }
    __host__ __device__ bool next(int i, Unit& u) const {
        const long L = (long)i * G + c; if (L >= nwg) return false;
        int wgid = (int)L; { const int q = nwg / NXCD, r = nwg % NXCD, xcd = wgid % NXCD, off = wgid / NXCD; wgid = (xcd < r ? xcd * (q + 1) : r * (q + 1) + (xcd - r) * q) + off; }
        const int nig = WGM * nN, gid = wgid / nig, fm = gid * WGM, gsz = (nM - fm) < WGM ? (nM - fm) : WGM;
        u.pm = fm + ((wgid % nig) % gsz); u.pn = (wgid % nig) / gsz; return true;
    }
};
template <class Epi>
__device__ __forceinline__ void gemm_phase(LAS unsigned char* lds, const Gemm g, const StaticOrder& S, const Epi& E) {
    const int tid = opaque_tid(), wid = __builtin_amdgcn_readfirstlane(tid >> 6), lane = tid & 63, wr = wid >> 2, wc = wid & 3, fr = lane & 15, fq = lane >> 4;
    const int K = g.K, nt = K / BK;
    unsigned voffA[2], voffB[2];
#pragma unroll
    for (int i = 0; i < 2; ++i) { int R, C; stage_rc(tid * 16 + i * 8192, R, C); const int Rb = E.perm ? ((R & ~31) + perm32(R & 31)) : R;
        voffA[i] = (unsigned)(R * K + C) * 2u; voffB[i] = (unsigned)(Rb * K + C) * 2u; }
    const size_t kstep = (size_t)(BK * 2);
    const size_t hstep = (size_t)HALF * K * 2;
    const size_t tstep = 2 * hstep;
    const unsigned ldsw = (unsigned)wid * 1024u;
    const int aoff = lds_byte(wr * 64 + fr, fq * 8), boff = lds_byte(wc * 32 + fr, fq * 8);
#define PG8_SA(b, h) (((b) * 2 + (h)) * HTB)
#define PG8_SB(b, h) ((4 + (b) * 2 + (h)) * HTB)
#define PG8_STAGE(bufoff, gbase, voff) do { _Pragma("unroll") for (int _i = 0; _i < 2; ++_i) \
        __builtin_amdgcn_global_load_lds((const unsigned*)((const char*)(gbase) + (voff)[_i]), (LAS unsigned*)(lds + (bufoff) + ldsw + _i * 8192), 16, 0, 0); } while (0)
#define PG8_LDA(dst, b, h) do { _Pragma("unroll") for (int m = 0; m < 4; ++m) _Pragma("unroll") for (int k = 0; k < 2; ++k) dst[m][k] = *(const LAS bf16x8*)(lds + PG8_SA(b, h) + aoff + m * 2048 + k * 1024); } while (0)
#define PG8_LDB(dst, b, h) do { _Pragma("unroll") for (int n = 0; n < 2; ++n) _Pragma("unroll") for (int k = 0; k < 2; ++k) dst[n][k] = *(const LAS bf16x8*)(lds + PG8_SB(b, h) + boff + n * 2048 + k * 1024); } while (0)
#define PG8_MMA(ai, bj, At, Bt) do { __builtin_amdgcn_s_setprio(1); _Pragma("unroll") for (int m = 0; m < 4; ++m) _Pragma("unroll") for (int n = 0; n < 2; ++n) _Pragma("unroll") for (int k = 0; k < 2; ++k) \
        acc[ai][bj][m][n] = __builtin_amdgcn_mfma_f32_16x16x32_bf16(Bt[n][k], At[m][k], acc[ai][bj][m][n], 0, 0, 0); __builtin_amdgcn_s_setprio(0); } while (0)
#define PG8_WAIT_V(n) asm volatile("s_waitcnt vmcnt(" #n ")" ::: "memory")
#define PG8_WAIT_L(n) asm volatile("s_waitcnt lgkmcnt(" #n ")" ::: "memory")
#define PG8_BAR __builtin_amdgcn_s_barrier()
#define PG8_SCHED __builtin_amdgcn_sched_barrier(0)
    Unit cur, nxt; int ui = 0;
    if (!S.next(0, cur)) return;
    f32x4 acc[2][2][4][2];
#pragma unroll
    for (int a = 0; a < 2; ++a)
#pragma unroll
        for (int b = 0; b < 2; ++b)
#pragma unroll
            for (int m = 0; m < 4; ++m)
#pragma unroll
                for (int n = 0; n < 2; ++n) acc[a][b][m][n] = (f32x4){0.f, 0.f, 0.f, 0.f};
    bf16x8 At[4][2], B0[2][2], B1[2][2];
    const char* cA = (const char*)g.A + (size_t)cur.pm * tstep; const char* cB = (const char*)g.Bt + (size_t)cur.pn * tstep;
    PG8_STAGE(PG8_SB(0, 0), cB, voffB); PG8_STAGE(PG8_SB(0, 1), cB + hstep, voffB); PG8_STAGE(PG8_SA(0, 0), cA, voffA); PG8_STAGE(PG8_SA(0, 1), cA + hstep, voffA);
    if (wr == 1) PG8_BAR;
    PG8_WAIT_V(2); PG8_BAR;
    PG8_STAGE(PG8_SB(1, 0), cB + kstep, voffB); PG8_STAGE(PG8_SA(1, 0), cA + kstep, voffA); PG8_STAGE(PG8_SB(1, 1), cB + hstep + kstep, voffB);
    PG8_WAIT_V(6); PG8_BAR;
    for (;;) {
        const bool has_next = S.next(ui + 1, nxt);
        const char* nA = has_next ? (const char*)g.A + (size_t)nxt.pm * tstep : cA; const char* nB = has_next ? (const char*)g.Bt + (size_t)nxt.pn * tstep : cB;
        for (int t = 0; t < nt; t += 2) {
            const bool last = (t == nt - 2);
            const char* a1 = cA + (size_t)(t + 1) * kstep;
            const char* a2 = last ? nA : cA + (size_t)(t + 2) * kstep; const char* b2 = last ? nB : cB + (size_t)(t + 2) * kstep;
            const char* a3 = a2 + kstep; const char* b3 = b2 + kstep;
            PG8_LDB(B0, 0, 0); PG8_LDB(B1, 0, 1); PG8_SCHED; PG8_LDA(At, 0, 0); PG8_STAGE(PG8_SA(1, 1), a1 + hstep, voffA);
            PG8_WAIT_V(8); PG8_WAIT_L(0); PG8_BAR; PG8_MMA(0, 0, At, B0); PG8_MMA(0, 1, At, B1); PG8_BAR; PG8_SCHED;
            PG8_LDA(At, 0, 1); PG8_STAGE(PG8_SB(0, 0), b2, voffB); PG8_STAGE(PG8_SB(0, 1), b2 + hstep, voffB); PG8_STAGE(PG8_SA(0, 0), a2, voffA);
            PG8_WAIT_V(8); PG8_WAIT_L(0); PG8_BAR; PG8_MMA(1, 0, At, B0); PG8_MMA(1, 1, At, B1); PG8_BAR; PG8_SCHED;
            PG8_LDB(B0, 1, 0); PG8_LDB(B1, 1, 1); PG8_SCHED; PG8_LDA(At, 1, 0); PG8_STAGE(PG8_SA(0, 1), a2 + hstep, voffA);
            PG8_WAIT_V(8); PG8_WAIT_L(0); PG8_BAR; PG8_MMA(0, 0, At, B0); PG8_MMA(0, 1, At, B1); PG8_BAR; PG8_SCHED;
            PG8_LDA(At, 1, 1); PG8_STAGE(PG8_SB(1, 0), b3, voffB); PG8_STAGE(PG8_SB(1, 1), b3 + hstep, voffB); PG8_STAGE(PG8_SA(1, 0), a3, voffA);
            PG8_WAIT_V(8); PG8_WAIT_L(0); PG8_BAR; PG8_MMA(1, 0, At, B0); PG8_MMA(1, 1, At, B1); PG8_BAR; PG8_SCHED;
        }
        if (wr == 0) PG8_BAR;
        E(acc, cur, wr, wc, fr, fq);
        if (!has_next) break;
#pragma unroll
        for (int a = 0; a < 2; ++a)
#pragma unroll
            for (int b = 0; b < 2; ++b)
#pragma unroll
                for (int m = 0; m < 4; ++m)
#pragma unroll
                    for (int n = 0; n < 2; ++n) acc[a][b][m][n] = (f32x4){0.f, 0.f, 0.f, 0.f};
        cur = nxt; cA = nA; cB = nB; ++ui;
        if (wr == 1) PG8_BAR;
    }
    PG8_WAIT_V(0);
    PG8_BAR;
#undef PG8_SA
#undef PG8_SB
#undef PG8_STAGE
#undef PG8_LDA
#undef PG8_LDB
#undef PG8_MMA
#undef PG8_WAIT_V
#undef PG8_WAIT_L
#undef PG8_BAR
#undef PG8_SCHED
}

typedef const f32x4 (&AccRef)[2][2][4][2];
struct EpiAny { int kind; bool perm; bf16_t* O; int ldc; const bf16_t* Hs; float* dt; const bf16_t* PE; bf16_t* HB; const u64_t* rin; u64_t* rout;
    __device__ __forceinline__ void operator()(AccRef acc, const Unit& u, int wr, int wc, int fr, int fq) const {
        const int row0 = u.pm * BM + wr * 64 + fr, col0 = u.pn * BM + wc * 32 + 8 * fq;
        if (kind == 1 || kind == 4) {
#pragma unroll
            for (int ai = 0; ai < 2; ++ai) {
                u32x4 hw[4][2], pw[4][2]; float rsv[4];
#pragma unroll
                for (int m = 0; m < 4; ++m) { const int row = row0 + ai * HALF + m * 16; const size_t ro = (size_t)row * DM + col0;
                    rsv[m] = 1.f; if (kind == 4) rsv[m] = (float)rin[row];
#pragma unroll
                    for (int bj = 0; bj < 2; ++bj) { hw[m][bj] = *(const u32x4*)(Hs + ro + bj * HALF); if (kind == 4) pw[m][bj] = *(const u32x4*)(PE + ro + bj * HALF); else pw[m][bj] = (u32x4){0u, 0u, 0u, 0u}; } }
#pragma unroll
                for (int m = 0; m < 4; ++m) { const int row = row0 + ai * HALF + m * 16; const size_t ro = (size_t)row * DM + col0; float ssq = 0.f;
                    float rs = 1.f; if (kind == 4) rs = rsqrtf(rsv[m] * RSS_INV + EPS);
#pragma unroll
                    for (int bj = 0; bj < 2; ++bj) { f32x4 v0 = acc[ai][bj][m][0], v1 = acc[ai][bj][m][1];
                        float hf[8]; unpack8(hw[m][bj], hf);
                        if (kind == 4) { float pe[8]; unpack8(pw[m][bj], pe);
#pragma unroll
                            for (int j = 0; j < 4; ++j) { v0[j] = pe[j] * sigmoidf_(v0[j] * rs); v1[j] = pe[4 + j] * sigmoidf_(v1[j] * rs); } }
#pragma unroll
                        for (int j = 0; j < 4; ++j) { v0[j] += hf[j]; v1[j] += hf[4 + j]; }
                        ssq += (v0.x * v0.x + v0.y * v0.y) + (v0.z * v0.z + v0.w * v0.w) + (v1.x * v1.x + v1.y * v1.y) + (v1.z * v1.z + v1.w * v1.w);
                        u32x4 w; w.x = cvtpk(v0[0], v0[1]); w.y = cvtpk(v0[2], v0[3]); w.z = cvtpk(v1[0], v1[1]); w.w = cvtpk(v1[2], v1[3]);
                        *(u32x4*)(HB + ro + bj * HALF) = w; }
                    ssq += __shfl_xor(ssq, 16); ssq += __shfl_xor(ssq, 32);
                    if (fq == 0) atomicAdd(rout + row, (u64_t)(ssq * RSS_SCALE)); }
                asm volatile("" ::: "memory"); }
        } else {
            const bool sq = (kind == 2), nrm = (kind != 3);
#pragma unroll
            for (int ai = 0; ai < 2; ++ai)
#pragma unroll
                for (int m = 0; m < 4; ++m) { const int row = row0 + ai * HALF + m * 16; bf16_t* rowp = O + (size_t)row * ldc + col0;
                    float rs = 1.f; if (nrm) rs = rsqrtf((float)rin[row] * RSS_INV + EPS);
#pragma unroll
                    for (int bj = 0; bj < 2; ++bj) { f32x4 v0 = acc[ai][bj][m][0] * rs, v1 = acc[ai][bj][m][1] * rs;
                        if (sq) {
#pragma unroll
                            for (int j = 0; j < 4; ++j) { const float a = fmaxf(v0[j], 0.f), b = fmaxf(v1[j], 0.f); v0[j] = a * a; v1[j] = b * b; } }
                        u32x4 w; w.x = cvtpk(v0[0], v0[1]); w.y = cvtpk(v0[2], v0[3]); w.z = cvtpk(v1[0], v1[1]); w.w = cvtpk(v1[2], v1[3]);
                        *(u32x4*)(rowp + bj * HALF) = w; }
                    if (kind == 0 && u.pn == DTOFF / BM && wc == 0) { float* dp = dt + (size_t)row * 32 + 8 * fq; *(f32x4*)dp = acc[ai][0][m][0] * rs; *(f32x4*)(dp + 4) = acc[ai][0][m][1] * rs; } }
        }
    }
};
}

struct Params { const float* in[30]; float* out; unsigned char* ws; int ph_lo, ph_hi; };
typedef const __attribute__((address_space(4))) Params CP;
enum { I_XP = 0, I_XS, I_PP, I_PS, I_NMIXG, I_WIN, I_CONVW, I_CONVB, I_CNG, I_CNB, I_SCW, I_SCB, I_DTB, I_ALOG, I_SSDD, I_SSDNG, I_LQ1, I_LK1, I_LQ2, I_LK2, I_SUBLN, I_RELB, I_WOUT, I_NMLPG, I_WUP, I_WDN, I_NPLEG, I_WPLE, I_WG, I_FNG };

__device__ __forceinline__ void seq_of(int sq, int& start, int& len) { if (sq < 4) { start = sq * 2048; len = 2048; } else { start = TP + (sq - 4) * 4096; len = 4096; } }
__device__ __forceinline__ void seq_bounds_of_tok(int t, int& start, int& end) { if (t < TP) { start = t & ~2047; end = start + 2048; } else { start = TP + ((t - TP) & ~4095); end = start + 4096; } }

__device__ __forceinline__ int map_in_col(int nd) {
    if (nd < QOFF) return nd;
    if (nd < DTOFF) return nd + 24;
    if (nd < DTOFF + 24) return nd - DTOFF + QOFF;
    return -1;
}
template <bool MAPIN>
__device__ __forceinline__ void transpose_item(const float* W, const float* gk, int K, int Nsrc, int nblk, bf16_t* WT, LAS float* scr, int item, int lane) {
    const int kb = item / nblk, nb = item % nblk, k0 = 64 * kb, n0 = 32 * nb;
    const int nd = n0 + (lane & 31); const int ns = MAPIN ? map_in_col(nd) : nd;
#pragma unroll 8
    for (int i = 0; i < 32; ++i) { const int kk = 2 * i + (lane >> 5); const float gg = gk ? gk[k0 + kk] : 1.f; scr[kk * 33 + (lane & 31)] = (ns >= 0) ? W[(size_t)(k0 + kk) * Nsrc + ns] * gg : 0.f; }
    asm volatile("s_waitcnt lgkmcnt(0)" ::: "memory");
    const int c = lane & 7;
#pragma unroll
    for (int j = 0; j < 4; ++j) { const int n = (lane >> 3) + 8 * j; const LAS float* s = scr + (8 * c) * 33 + n;
        u32x4 o; o.x = cvtpk(s[0 * 33], s[1 * 33]); o.y = cvtpk(s[2 * 33], s[3 * 33]); o.z = cvtpk(s[4 * 33], s[5 * 33]); o.w = cvtpk(s[6 * 33], s[7 * 33]);
        *(u32x4*)(WT + (size_t)(n0 + n) * K + k0 + 8 * c) = o; }
    asm volatile("s_waitcnt lgkmcnt(0)" ::: "memory");
}
__device__ __forceinline__ void prep_row(const float* src, bf16_t* hb, u64_t* rss, int lane) {
    const f32x4* xr = (const f32x4*)src + lane; f32x4 v[8]; float s = 0.f;
#pragma unroll
    for (int j = 0; j < 8; ++j) { v[j] = xr[64 * j]; s += (v[j].x * v[j].x + v[j].y * v[j].y) + (v[j].z * v[j].z + v[j].w * v[j].w); }
    s = wave_sum(s);
#pragma unroll
    for (int j = 0; j < 8; ++j) { u32x2 w; w.x = cvtpk(v[j].x, v[j].y); w.y = cvtpk(v[j].z, v[j].w); ((u32x2*)hb + lane)[64 * j] = w; }
    if (lane == 0) *rss = (u64_t)(s * RSS_SCALE);
}
__device__ __forceinline__ void final_row(const bf16_t* h, float* out, const float* g, u64_t ss, int lane) {
    const float rstd = rsqrtf((float)ss * RSS_INV + EPS);
    const u32x2* hr = (const u32x2*)h + lane; f32x4* orow = (f32x4*)out + lane; const f32x4* gr = (const f32x4*)g + lane;
#pragma unroll
    for (int j = 0; j < 8; ++j) { const u32x2 w = hr[64 * j]; const f32x4 gg = gr[64 * j];
        f32x4 v; v.x = __uint_as_float(w.x << 16); v.y = __uint_as_float(w.x & 0xffff0000u); v.z = __uint_as_float(w.y << 16); v.w = __uint_as_float(w.y & 0xffff0000u);
        orow[64 * j] = v * rstd * gg; }
}

__device__ __forceinline__ void conv_module_item(CP& P, int L, int item, LAS unsigned char* lds) {
    const int tid = opaque_tid(), lane = tid & 63, wid = tid >> 6;
    const bf16_t* proj = (const bf16_t*)(P.ws + WS_PROJ); bf16_t* mix = (bf16_t*)(P.ws + WS_MIX);
    const int t0 = item * 32; int s0, s1; seq_bounds_of_tok(t0, s0, s1);
    LAS float* U = (LAS float*)lds;
#pragma unroll
    for (int i = 0; i < 8; ++i) { const int id = tid + 512 * i, rr = id >> 6, c8 = (id & 63) * 8; const int t = t0 - 15 + rr;
        if (rr < 62) { f32x4 u0 = {0.f, 0.f, 0.f, 0.f}, u1 = {0.f, 0.f, 0.f, 0.f};
            if (t >= s0 && t < s1) { const u32x4 vv = *(const u32x4*)(proj + (size_t)t * PROJ_PITCH + c8), gv = *(const u32x4*)(proj + (size_t)t * PROJ_PITCH + 512 + c8);
                float v[8], g[8]; unpack8(vv, v); unpack8(gv, g);
#pragma unroll
                for (int j = 0; j < 4; ++j) { u0[j] = v[j] * sigmoidf_(g[j]); u1[j] = v[4 + j] * sigmoidf_(g[4 + j]); } }
            *(LAS f32x4*)(U + rr * 512 + c8) = u0; *(LAS f32x4*)(U + rr * 512 + c8 + 4) = u1; } }
    float w[31];
#pragma unroll
    for (int j = 0; j < 31; ++j) w[j] = P.in[I_CONVW][(size_t)L * 31 * 512 + j * 512 + tid];
    const float cb = P.in[I_CONVB][L * 512 + tid];
    __syncthreads();
    float o[32];
    {   float u[62];
#pragma unroll
        for (int rr = 0; rr < 62; ++rr) u[rr] = U[rr * 512 + tid];
#pragma unroll
        for (int tt = 0; tt < 32; ++tt) { float a = cb;
#pragma unroll
            for (int j = 0; j < 31; ++j) a += u[tt + j] * w[j];
            o[tt] = a; } }
    __syncthreads();
#pragma unroll
    for (int tt = 0; tt < 32; ++tt) U[tt * 512 + tid] = o[tt];
    __syncthreads();
    const f32x4 g0 = *((const f32x4*)(P.in[I_CNG] + L * 512) + 2 * lane), g1 = *((const f32x4*)(P.in[I_CNG] + L * 512) + 2 * lane + 1);
    const f32x4 b0 = *((const f32x4*)(P.in[I_CNB] + L * 512) + 2 * lane), b1 = *((const f32x4*)(P.in[I_CNB] + L * 512) + 2 * lane + 1);
#pragma unroll
    for (int k = 0; k < 4; ++k) { const int tt = wid * 4 + k;
        const f32x4 x0 = *((const LAS f32x4*)(U + tt * 512) + 2 * lane), x1 = *((const LAS f32x4*)(U + tt * 512) + 2 * lane + 1);
        const float mu = wave_sum((x0.x + x0.y) + (x0.z + x0.w) + (x1.x + x1.y) + (x1.z + x1.w)) * (1.f / 512.f);
        const f32x4 d0 = x0 - mu, d1 = x1 - mu;
        const float var = wave_sum((d0.x * d0.x + d0.y * d0.y) + (d0.z * d0.z + d0.w * d0.w) + (d1.x * d1.x + d1.y * d1.y) + (d1.z * d1.z + d1.w * d1.w)) * (1.f / 512.f);
        const float rstd = rsqrtf(var + EPS);
        f32x4 y0 = d0 * rstd * g0 + b0, y1 = d1 * rstd * g1 + b1;
#pragma unroll
        for (int j = 0; j < 4; ++j) { y0[j] = siluf_(y0[j]); y1[j] = siluf_(y1[j]); }
        u32x4 wv; wv.x = cvtpk(y0[0], y0[1]); wv.y = cvtpk(y0[2], y0[3]); wv.z = cvtpk(y1[0], y1[1]); wv.w = cvtpk(y1[2], y1[3]);
        *(u32x4*)(mix + (size_t)(t0 + tt) * DM + 8 * lane) = wv; }
    __syncthreads();
}
__device__ __forceinline__ void xbc_conv_item(CP& P, int L, int item) {
    const int tid = opaque_tid(); const int cg = tid % 160, rs = tid / 160; const int seg = item * 3 + rs;
    if (rs >= 3 || seg >= T / 32) return;
    const bf16_t* proj = (const bf16_t*)(P.ws + WS_PROJ); bf16_t* xbc = (bf16_t*)(P.ws + WS_XBC);
    const int c8 = cg * 8, r0 = seg * 32; int s0, s1; seq_bounds_of_tok(r0, s0, s1);
    const float* cw = P.in[I_SCW] + (size_t)L * 5 * XBC_W + c8; const float* cbp = P.in[I_SCB] + L * XBC_W + c8;
    float w[5][8], bs[8];
#pragma unroll
    for (int j = 0; j < 5; ++j) { const f32x4 a = *(const f32x4*)(cw + j * XBC_W), b = *(const f32x4*)(cw + j * XBC_W + 4); w[j][0] = a.x; w[j][1] = a.y; w[j][2] = a.z; w[j][3] = a.w; w[j][4] = b.x; w[j][5] = b.y; w[j][6] = b.z; w[j][7] = b.w; }
    { const f32x4 a = *(const f32x4*)cbp, b = *(const f32x4*)(cbp + 4); bs[0] = a.x; bs[1] = a.y; bs[2] = a.z; bs[3] = a.w; bs[4] = b.x; bs[5] = b.y; bs[6] = b.z; bs[7] = b.w; }
    const bf16_t* src = proj + XBCOFF + c8;
    u32x4 win[5];
#pragma unroll
    for (int j = 0; j < 4; ++j) { const int t = r0 - 2 + j; win[j + 1] = (t >= s0 && t < s1) ? *(const u32x4*)(src + (size_t)t * PROJ_PITCH) : (u32x4){0u, 0u, 0u, 0u}; }
#pragma unroll 4
    for (int r = 0; r < 32; ++r) {
#pragma unroll
        for (int j = 0; j < 4; ++j) win[j] = win[j + 1];
        { const int t = r0 + r + 2; win[4] = (t >= s0 && t < s1) ? *(const u32x4*)(src + (size_t)t * PROJ_PITCH) : (u32x4){0u, 0u, 0u, 0u}; }
        float a[8];
#pragma unroll
        for (int k = 0; k < 8; ++k) a[k] = bs[k];
#pragma unroll
        for (int j = 0; j < 5; ++j) { float x[8]; unpack8(win[j], x);
#pragma unroll
            for (int k = 0; k < 8; ++k) a[k] += x[k] * w[j][k]; }
#pragma unroll
        for (int k = 0; k < 8; ++k) a[k] = siluf_(a[k]);
        u32x4 o; o.x = cvtpk(a[0], a[1]); o.y = cvtpk(a[2], a[3]); o.z = cvtpk(a[4], a[5]); o.w = cvtpk(a[6], a[7]);
        *(u32x4*)(xbc + (size_t)(r0 + r) * XBC_W + c8) = o;
    }
}

#define MFMA32(a, b, c) __builtin_amdgcn_mfma_f32_32x32x16_bf16((a), (b), (c), 0, 0, 0)
__device__ __forceinline__ int crow(int r, int hi) { return (r & 3) + 8 * (r >> 2) + 4 * hi; }
__device__ __forceinline__ bf16x8 pack_step(const f32x16& x, int s) {
    u32x4 p; p.x = cvtpk(x[8 * s], x[8 * s + 1]); p.y = cvtpk(x[8 * s + 2], x[8 * s + 3]); p.z = cvtpk(x[8 * s + 4], x[8 * s + 5]); p.w = cvtpk(x[8 * s + 6], x[8 * s + 7]);
    return __builtin_bit_cast(bf16x8, p);
}

typedef short v4i16s_t __attribute__((ext_vector_type(4)));
constexpr int SP = 272, SXP = 144;
constexpr int S_CM = 0, S_BM = 128 * SP, S_BD = 2 * 128 * SP, S_XD = 3 * 128 * SP, S_PV = S_XD + 128 * SXP, S_AS = S_PV + 64 * SP, S_DTV = S_AS + 132 * 4, S_END = S_DTV + 128 * 4;
static_assert(S_END <= LDS_BYTES - 64, "ssd lds");
__device__ __forceinline__ bf16x8 ssd_trfrag(const LAS unsigned char* p, int pitch) {
    const s16x4 lo = __builtin_bit_cast(s16x4, __builtin_amdgcn_ds_read_tr16_b64_v4i16((LAS v4i16s_t*)p));
    const s16x4 hi = __builtin_bit_cast(s16x4, __builtin_amdgcn_ds_read_tr16_b64_v4i16((LAS v4i16s_t*)(p + 4 * pitch)));
    return __builtin_shufflevector(lo, hi, 0, 1, 2, 3, 4, 5, 6, 7);
}
__device__ __forceinline__ void ssd_item(CP& P, int L, int sq, int hd, int dir, LAS unsigned char* lds) {
    const int tid = opaque_tid(), lane = tid & 63, wid = __builtin_amdgcn_readfirstlane(tid >> 6), r = lane & 31, hi = lane >> 5;
    int sstart, slen; seq_of(sq, sstart, slen); const int nc = slen / 128, g = hd / 6;
    const bf16_t* xbc = (const bf16_t*)(P.ws + WS_XBC); const float* DT = (const float*)(P.ws + WS_DT);
    bf16_t* Y = (bf16_t*)(P.ws + (dir ? WS_YB : WS_YF));
    const float Aneg = -__expf(P.in[I_ALOG][L * 24 + dir * 12 + hd]), dtb = P.in[I_DTB][L * 24 + dir * 12 + hd]; const int dcol = dir * 12 + hd;
    LAS float* AS = (LAS float*)(lds + S_AS); LAS float* DTV = (LAS float*)(lds + S_DTV);
    f32x16 st;
#pragma unroll
    for (int i = 0; i < 16; ++i) st[i] = 0.f;
    for (int i = tid; i < 64 * SP / 4; i += 512) ((LAS unsigned*)(lds + S_PV))[i] = 0u;
    const int crow_ = tid >> 4, cch = tid & 15;
    const int xrow_ = tid >> 3, xch = tid & 7;
    const int lb = wid >> 1, pb = wid & 1, nb = wid >> 1;
    const int trq = (lane & 15) >> 2, trb = ((lane >> 4) & 1) * 32 + (lane & 3) * 8;
    const int xdo = S_XD + (8 * hi + trq) * SXP + 64 * pb + trb;
    const int bdo = S_BD + (8 * hi + trq) * SP + 64 * nb + trb;
    u32x4 cv[4], bv[4], xv[2]; float r0 = 0.f, r1 = 0.f;
#define SSD_LOAD(tk) do { const bf16_t* rp_ = xbc + (size_t)(tk) * XBC_W; \
        _Pragma("unroll") for (int i = 0; i < 4; ++i) { cv[i] = *(const u32x4*)(rp_ + (size_t)(crow_ + 32 * i) * XBC_W + 1024 + g * 128 + cch * 8); bv[i] = *(const u32x4*)(rp_ + (size_t)(crow_ + 32 * i) * XBC_W + 768 + g * 128 + cch * 8); } \
        _Pragma("unroll") for (int i = 0; i < 2; ++i) xv[i] = *(const u32x4*)(rp_ + (size_t)(xrow_ + 64 * i) * XBC_W + hd * 64 + xch * 8); \
        if (wid == 0) { r0 = DT[(size_t)((tk) + lane) * 32 + dcol]; r1 = DT[(size_t)((tk) + 64 + lane) * 32 + dcol]; } } while (0)
    SSD_LOAD(sstart + (dir ? nc - 1 : 0) * 128);
    for (int ci = 0; ci < nc; ++ci) {
        const int c = dir ? nc - 1 - ci : ci; const int tok0 = sstart + c * 128;
        if (wid == 0) {
            const float q0 = r0 + dtb, q1 = r1 + dtb;
            const float d0 = q0 > 20.f ? q0 : log1pf(__expf(q0)), d1 = q1 > 20.f ? q1 : log1pf(__expf(q1));
            const float x0 = d0 * Aneg, x1 = d1 * Aneg; float p0 = x0, p1 = x1;
#pragma unroll
            for (int o = 1; o < 64; o <<= 1) { const float t0 = __shfl_up(p0, o), t1 = __shfl_up(p1, o); if (lane >= o) { p0 += t0; p1 += t1; } }
            const float tot0 = __shfl(p0, 63), tot1 = __shfl(p1, 63); p1 += tot0; const float total = tot0 + tot1;
            float a0 = p0, a1 = p1; if (dir) { a0 = total - p0 + x0; a1 = total - p1 + x1; }
            AS[lane] = a0; AS[64 + lane] = a1; DTV[lane] = d0; DTV[64 + lane] = d1; if (lane == 0) AS[128] = total;
        }
        __syncthreads();
        { const float aend = AS[128];
#pragma unroll
          for (int i = 0; i < 4; ++i) { const int row = crow_ + 32 * i; const float dec = __expf(aend - AS[row]);
              *(LAS u32x4*)(lds + S_CM + row * SP + cch * 16) = cv[i]; *(LAS u32x4*)(lds + S_BM + row * SP + cch * 16) = bv[i];
              float f[8]; unpack8(bv[i], f); u32x4 w; w.x = cvtpk(f[0] * dec, f[1] * dec); w.y = cvtpk(f[2] * dec, f[3] * dec); w.z = cvtpk(f[4] * dec, f[5] * dec); w.w = cvtpk(f[6] * dec, f[7] * dec);
              *(LAS u32x4*)(lds + S_BD + row * SP + cch * 16) = w; }
#pragma unroll
          for (int i = 0; i < 2; ++i) { const int row = xrow_ + 64 * i; const float dtv = DTV[row]; float f[8]; unpack8(xv[i], f);
              u32x4 w; w.x = cvtpk(f[0] * dtv, f[1] * dtv); w.y = cvtpk(f[2] * dtv, f[3] * dtv); w.z = cvtpk(f[4] * dtv, f[5] * dtv); w.w = cvtpk(f[6] * dtv, f[7] * dtv);
              *(LAS u32x4*)(lds + S_XD + row * SXP + xch * 16) = w; } }
        if (ci + 1 < nc) SSD_LOAD(sstart + (dir ? nc - 2 - ci : ci + 1) * 128);
        __syncthreads();
        {   const int lrow = 32 * lb + r; const float a_l = AS[lrow];
            f32x16 yd, yo;
#pragma unroll
            for (int i = 0; i < 16; ++i) { yd[i] = 0.f; yo[i] = 0.f; }
            const int sb0 = dir ? lb : 0, sb1 = dir ? 4 : lb + 1;
#pragma unroll
            for (int sb = 0; sb < 4; ++sb) if (sb >= sb0 && sb < sb1) {
                f32x16 cb;
#pragma unroll
                for (int i = 0; i < 16; ++i) cb[i] = 0.f;
#pragma unroll
                for (int ks = 0; ks < 8; ++ks) { const bf16x8 av = *(const LAS bf16x8*)(lds + S_BM + (32 * sb + r) * SP + (16 * ks + 8 * hi) * 2);
                    const bf16x8 bv2 = *(const LAS bf16x8*)(lds + S_CM + lrow * SP + (16 * ks + 8 * hi) * 2); cb = MFMA32(av, bv2, cb); }
#pragma unroll
                for (int i = 0; i < 16; ++i) { const int sr = 32 * sb + crow(i, hi); const bool ok = dir ? (sr >= lrow) : (sr <= lrow); const float gv = cb[i] * __expf(a_l - AS[sr]); cb[i] = ok ? gv : 0.f; }
#pragma unroll
                for (int s2 = 0; s2 < 2; ++s2) { const LAS unsigned char* xp = lds + S_XD + (32 * sb + 16 * s2 + 4 * hi + trq) * SXP + 64 * pb + trb;
                    const s16x4 lo = __builtin_bit_cast(s16x4, __builtin_amdgcn_ds_read_tr16_b64_v4i16((LAS v4i16s_t*)xp));
                    const s16x4 hi4 = __builtin_bit_cast(s16x4, __builtin_amdgcn_ds_read_tr16_b64_v4i16((LAS v4i16s_t*)(xp + 8 * SXP)));
                    const bf16x8 xa = __builtin_shufflevector(lo, hi4, 0, 1, 2, 3, 4, 5, 6, 7);
                    yd = MFMA32(xa, pack_step(cb, s2), yd); }
            }
#pragma unroll
            for (int ks = 0; ks < 8; ++ks) { const bf16x8 av = *(const LAS bf16x8*)(lds + S_PV + (32 * pb + r) * SP + (16 * ks + 8 * hi) * 2);
                const bf16x8 bv2 = *(const LAS bf16x8*)(lds + S_CM + lrow * SP + (16 * ks + 8 * hi) * 2); yo = MFMA32(av, bv2, yo); }
            const float el = __expf(a_l);
            bf16_t* yp = Y + (size_t)(tok0 + lrow) * SSD_W + hd * 64 + 32 * pb + 4 * hi;
#pragma unroll
            for (int g4 = 0; g4 < 4; ++g4) { u32x2 w; w.x = cvtpk(yd[4 * g4] + el * yo[4 * g4], yd[4 * g4 + 1] + el * yo[4 * g4 + 1]); w.y = cvtpk(yd[4 * g4 + 2] + el * yo[4 * g4 + 2], yd[4 * g4 + 3] + el * yo[4 * g4 + 3]);
                *(u32x2*)(yp + 8 * g4) = w; }
            const float cd = __expf(AS[128]);
#pragma unroll
            for (int i = 0; i < 16; ++i) st[i] *= cd;
#pragma unroll
            for (int ks = 0; ks < 8; ++ks) { const bf16x8 xa = ssd_trfrag(lds + xdo + 16 * ks * SXP, SXP); const bf16x8 bb = ssd_trfrag(lds + bdo + 16 * ks * SP, SP); st = MFMA32(xa, bb, st); }
        }
        __syncthreads();
#pragma unroll
        for (int i = 0; i < 16; ++i) *(LAS bf16_t*)(lds + S_PV + (32 * pb + crow(i, hi)) * SP + (32 * nb + r) * 2) = f2bf(st[i]);
    }
    __syncthreads();
#undef SSD_LOAD
}

typedef short v4i16_t __attribute__((ext_vector_type(4)));
constexpr int A_SLOT = 32768, A_VI = 16384, A_NSLOT = 4, A_TBL = A_NSLOT * A_SLOT, A_O2P = 132;
static_assert(A_TBL + 260 * 4 <= LDS_BYTES - 64 && 128 * A_O2P * 4 <= A_TBL, "attn lds");
__device__ __forceinline__ void attn_item(CP& P, int L, int sq, int hh, int qt, float lam, float lam_init, LAS unsigned char* lds) {
    const int tid = opaque_tid(), lane = tid & 63, wid = __builtin_amdgcn_readfirstlane(tid >> 6), r = lane & 31, hi = lane >> 5, map = wid >> 2, wq = wid & 3;
    int sstart, slen; seq_of(sq, sstart, slen); const int ntiles = slen / 64;
    const bf16_t* proj = (const bf16_t*)(P.ws + WS_PROJ); bf16_t* mix = (bf16_t*)(P.ws + WS_MIX);
    LAS float* tbl = (LAS float*)(lds + A_TBL);
    if (tid < 257) { const int rel = tid - 128; const int n = rel < 0 ? -rel : rel; int bk;
        if (n < 8) bk = n; else { int k = (31 - __builtin_clz((unsigned)(n * n))) - 6; bk = 8 + k; if (bk > 15) bk = 15; }
        if (rel > 0) bk += 16;
        tbl[tid] = P.in[I_RELB][bk * 6 + hh] * LOG2E; }
    const int qpos = qt * 128 + wq * 32 + r;
    const float SC = 0.125f * LOG2E;
    bf16x8 qf[4];
    { const bf16_t* qp = proj + (size_t)(sstart + qpos) * PROJ_PITCH + QOFF + hh * 128 + map * 64 + hi * 8;
#pragma unroll
      for (int s = 0; s < 4; ++s) { const u32x4 w = *(const u32x4*)(qp + 16 * s); float f[8]; unpack8(w, f); u32x4 o4;
          o4.x = cvtpk(f[0] * SC, f[1] * SC); o4.y = cvtpk(f[2] * SC, f[3] * SC); o4.z = cvtpk(f[4] * SC, f[5] * SC); o4.w = cvtpk(f[6] * SC, f[7] * SC); qf[s] = __builtin_bit_cast(bf16x8, o4); } }
    f32x16 o[4];
#pragma unroll
    for (int c = 0; c < 4; ++c)
#pragma unroll
        for (int i = 0; i < 16; ++i) o[c][i] = 0.f;
    float mref = 0.f, lrun = 0.f;
    const bf16_t* gk[2]; const bf16_t* gv[2];
#pragma unroll
    for (int i = 0; i < 2; ++i) { const int n = 2 * wid + i;
        { const int rr = 8 * (n & 7) + (lane >> 3), c = (lane & 7) ^ ((rr >> 1) & 7); gk[i] = proj + (size_t)(sstart + rr) * PROJ_PITCH + KOFF + hh * 128 + (n >> 3) * 64 + c * 8; }
        { const int rr = 4 * n + (lane >> 4), ch = (lane & 15) ^ (4 * (rr & 3)); gv[i] = proj + (size_t)(sstart + rr) * PROJ_PITCH + VOFF + hh * 128 + ch * 8; } }
#define ATT_DMA(t, slot) do { const size_t to_ = (size_t)(t) * 64 * PROJ_PITCH; LAS unsigned char* sd_ = lds + (slot) * A_SLOT + wid * 2048; \
        _Pragma("unroll") for (int i = 0; i < 2; ++i) { \
            __builtin_amdgcn_global_load_lds((const unsigned*)(gk[i] + to_), (LAS unsigned*)(sd_ + i * 1024), 16, 0, 0); \
            __builtin_amdgcn_global_load_lds((const unsigned*)(gv[i] + to_), (LAS unsigned*)(sd_ + A_VI + i * 1024), 16, 0, 0); } } while (0)
#define ATT_WAITBAR(N) do { asm volatile("s_waitcnt vmcnt(" #N ") lgkmcnt(0)" ::: "memory"); __builtin_amdgcn_s_barrier(); asm volatile("" ::: "memory"); } while (0)
    const int q0w = qt * 128 + wq * 32;
    const int m7 = (r >> 1) & 7;
    const int kfo = map * 8192 + r * 128;
    int kso[4];
#pragma unroll
    for (int s = 0; s < 4; ++s) kso[s] = ((2 * s + hi) ^ m7) * 16;
    const int vq = (lane & 15) >> 2;
    const int vfo = A_VI + (4 * hi + vq) * 256 + ((lane >> 4) & 1) * 32 + (lane & 3) * 8;
    bf16x8 pf[2][2];
    f32x16 p[2];
#define SB() __builtin_amdgcn_sched_barrier(0)
#define ATT_KRD(sbuf) do { const unsigned ka_ = (unsigned)(size_t)(lds + (sbuf) * A_SLOT + kfo); \
        _Pragma("unroll") for (int s_ = 0; s_ < 4; ++s_) { const unsigned kas_ = ka_ + (unsigned)kso[s_]; \
            asm volatile("ds_read_b128 %0, %1" : "=&v"(kf[s_]) : "v"(kas_) : "memory"); \
            asm volatile("ds_read_b128 %0, %1 offset:4096" : "=&v"(kf[4 + s_]) : "v"(kas_) : "memory"); } } while (0)
#define ATT_QKM(t) do { _Pragma("unroll") for (int kb = 0; kb < 2; ++kb) _Pragma("unroll") for (int i = 0; i < 16; ++i) p[kb][i] = cinit_; \
        SB(); __builtin_amdgcn_s_setprio(1); \
        _Pragma("unroll") for (int s_ = 0; s_ < 4; ++s_) _Pragma("unroll") for (int kb = 0; kb < 2; ++kb) p[kb] = MFMA32(kf[kb * 4 + s_], qf[s_], p[kb]); \
        __builtin_amdgcn_s_setprio(0); SB(); } while (0)
#define ATT_TR(dst, addr, off) asm volatile("ds_read_b64_tr_b16 %0, %1 offset:%c2" : "=&v"(dst) : "v"(addr), "i"(off) : "memory")
#define ATT_LWAIT() asm volatile("s_waitcnt lgkmcnt(0)" ::: "memory")
#define ATT_VRD(dst, c) do { const unsigned va_ = vaddr_ + 64u * (unsigned)((c) ^ vq); \
        ATT_TR(dst[0], va_, 0);     ATT_TR(dst[1], va_, 2048);  ATT_TR(dst[2], va_, 4096);  ATT_TR(dst[3], va_, 6144); \
        ATT_TR(dst[4], va_, 8192);  ATT_TR(dst[5], va_, 10240); ATT_TR(dst[6], va_, 12288); ATT_TR(dst[7], va_, 14336); } while (0)
#define ATT_VMM(src, c) do { __builtin_amdgcn_s_setprio(1); _Pragma("unroll") for (int kb = 0; kb < 2; ++kb) _Pragma("unroll") for (int s_ = 0; s_ < 2; ++s_) { \
            const bf16x8 vb_ = __builtin_shufflevector(src[2 * (kb * 2 + s_)], src[2 * (kb * 2 + s_) + 1], 0, 1, 2, 3, 4, 5, 6, 7); \
            o[c] = MFMA32(vb_, pf[kb][s_], o[c]); } __builtin_amdgcn_s_setprio(0); } while (0)
#define ATT_VMM2(srca, ca, srcb, cb) do { __builtin_amdgcn_s_setprio(1); _Pragma("unroll") for (int kb = 0; kb < 2; ++kb) _Pragma("unroll") for (int s_ = 0; s_ < 2; ++s_) { \
            const bf16x8 va_ = __builtin_shufflevector(srca[2 * (kb * 2 + s_)], srca[2 * (kb * 2 + s_) + 1], 0, 1, 2, 3, 4, 5, 6, 7); \
            const bf16x8 vb_ = __builtin_shufflevector(srcb[2 * (kb * 2 + s_)], srcb[2 * (kb * 2 + s_) + 1], 0, 1, 2, 3, 4, 5, 6, 7); \
            o[ca] = MFMA32(va_, pf[kb][s_], o[ca]); o[cb] = MFMA32(vb_, pf[kb][s_], o[cb]); } __builtin_amdgcn_s_setprio(0); } while (0)
#define ATT_PV(sbuf) do { const unsigned vaddr_ = (unsigned)(size_t)(lds + (sbuf) * A_SLOT + vfo); s16x4 va0_[8], va1_[8]; \
        ATT_VRD(va0_, 0); ATT_VRD(va1_, 1); ATT_LWAIT(); SB(); ATT_VMM2(va0_, 0, va1_, 1); SB(); \
        ATT_VRD(va0_, 2); ATT_VRD(va1_, 3); ATT_LWAIT(); SB(); ATT_VMM2(va0_, 2, va1_, 3); SB(); } while (0)
#define ATT_SOFTMAX(t) do { const int k0_ = (t) * 64; \
        if (!far_) { _Pragma("unroll") for (int kb = 0; kb < 2; ++kb) _Pragma("unroll") for (int i = 0; i < 16; ++i) { \
            int rel_ = k0_ + kb * 32 + crow(i, hi) - qpos; rel_ = rel_ < -128 ? -128 : (rel_ > 128 ? 128 : rel_); p[kb][i] += tbl[rel_ + 128]; } } \
        float mx_; bool resc_; \
        if ((t) == 0) { mx_ = fmaxf(p[0][0], p[1][0]); _Pragma("unroll") for (int i = 1; i < 16; ++i) mx_ = fmaxf(mx_, fmaxf(p[0][i], p[1][i])); mx_ = fmaxf(mx_, __shfl_xor(mx_, 32)); resc_ = true; } \
        else { int im_ = __float_as_int(p[0][0]);   \
            _Pragma("unroll") for (int i = 0; i < 16; ++i) { const int a_ = __float_as_int(p[0][i]), b_ = __float_as_int(p[1][i]); im_ = (im_ > a_ ? im_ : a_); im_ = (im_ > b_ ? im_ : b_); } \
            const int io_ = __shfl_xor(im_, 32); im_ = im_ > io_ ? im_ : io_; mx_ = __int_as_float(im_); resc_ = __any(im_ > 0x41000000); } \
        if (resc_) { \
            const float dl_ = ((t) == 0) ? mx_ : (mx_ > 0.f ? mx_ : 0.f); mref += dl_; const float f_ = __builtin_amdgcn_exp2f(-dl_); lrun *= f_; \
            _Pragma("unroll") for (int kb = 0; kb < 2; ++kb) _Pragma("unroll") for (int i = 0; i < 16; ++i) p[kb][i] -= dl_; \
            _Pragma("unroll") for (int c = 0; c < 4; ++c) _Pragma("unroll") for (int i = 0; i < 16; ++i) o[c][i] *= f_; } \
        f32x2 ls_ = {0.f, 0.f}; \
        _Pragma("unroll") for (int i = 0; i < 16; ++i) { f32x2 e_; e_.x = __builtin_amdgcn_exp2f(p[0][i]); e_.y = __builtin_amdgcn_exp2f(p[1][i]); p[0][i] = e_.x; p[1][i] = e_.y; ls_ += e_; } \
        lrun += ls_.x + ls_.y; \
        _Pragma("unroll") for (int kb = 0; kb < 2; ++kb) _Pragma("unroll") for (int s_ = 0; s_ < 2; ++s_) pf[kb][s_] = pack_step(p[kb], s_); } while (0)
    bool far_ = false;
    ATT_DMA(0, 0); ATT_DMA((1 < ntiles ? 1 : ntiles - 1), 1);
    ATT_WAITBAR(4);
    bf16x8 kf[8];
    for (int t = 0; t < ntiles; ++t) {
        { const int tn = (t + 2 < ntiles) ? t + 2 : ntiles - 1; ATT_DMA(tn, (t + 2) & 3); }
        const int k0_ = t * 64; const bool farR_ = (k0_ - (q0w + 31) >= 128), farL_ = (q0w - (k0_ + 63) >= 128); far_ = farR_ || farL_;
        const float cinit_ = (far_ ? (farR_ ? tbl[256] : tbl[0]) : 0.f) - mref;
        if (t > 0) {
            const unsigned vaddr_ = (unsigned)(size_t)(lds + ((t - 1) & 3) * A_SLOT + vfo); s16x4 va0_[8], va1_[8];
            ATT_VRD(va0_, 0); ATT_VRD(va1_, 1); ATT_LWAIT(); SB();
            ATT_VMM2(va0_, 0, va1_, 1); SB();
            ATT_VRD(va0_, 2); ATT_VRD(va1_, 3); ATT_LWAIT(); ATT_KRD(t & 3); SB();
            ATT_VMM2(va0_, 2, va1_, 3); SB(); ATT_LWAIT(); SB();
        } else { ATT_KRD(0); ATT_LWAIT(); SB(); }
        ATT_QKM(t);
        ATT_SOFTMAX(t);
        ATT_WAITBAR(4);
    }
    ATT_PV((ntiles - 1) & 3);
    __builtin_amdgcn_s_setprio(0);
    asm volatile("s_waitcnt vmcnt(0)" ::: "memory");
    __syncthreads();
#undef ATT_DMA
#undef ATT_WAITBAR
#undef ATT_KRD
#undef ATT_QKM
#undef ATT_PV
#undef ATT_VRD
#undef ATT_VMM
#undef ATT_VMM2
#undef ATT_TR
#undef ATT_LWAIT
#undef ATT_SOFTMAX
#undef SB
    lrun += __shfl_xor(lrun, 32);
    const float inv = 1.f / lrun;
    LAS float* O2 = (LAS float*)lds;
    if (map == 1) {
#pragma unroll
        for (int c = 0; c < 4; ++c)
#pragma unroll
            for (int i = 0; i < 16; ++i) O2[(wq * 32 + r) * A_O2P + 32 * c + crow(i, hi)] = o[c][i] * inv;
    }
    __syncthreads();
    if (map == 0) {
        float ss = 0.f;
#pragma unroll
        for (int c = 0; c < 4; ++c)
#pragma unroll
            for (int i = 0; i < 16; ++i) { const float v = o[c][i] * inv - lam * O2[(wq * 32 + r) * A_O2P + 32 * c + crow(i, hi)]; o[c][i] = v; ss += v * v; }
        ss += __shfl_xor(ss, 32);
        const float rstd = rsqrtf(ss * (1.f / 128.f) + EPS) * (1.f - lam_init);
        const float* sg = P.in[I_SUBLN] + L * 128;
        bf16_t* op = mix + (size_t)(sstart + qpos) * DM + 1280 + hh * 128;
#pragma unroll
        for (int c = 0; c < 4; ++c)
#pragma unroll
            for (int gq = 0; gq < 4; ++gq) { const int dv = 32 * c + 8 * gq + 4 * hi; const f32x4 gg = *(const f32x4*)(sg + dv);
                u32x2 w; w.x = cvtpk(o[c][4 * gq] * rstd * gg.x, o[c][4 * gq + 1] * rstd * gg.y); w.y = cvtpk(o[c][4 * gq + 2] * rstd * gg.z, o[c][4 * gq + 3] * rstd * gg.w);
                *(u32x2*)(op + dv) = w; }
    }
    __syncthreads();
}

#define XB_TMO      128
#define XB_XCNT(j)  (256  + 64 * (j))
#define XB_XSUB(j)  (1280 + 64 * (j))
#define XB_XGEN(j)  (2304 + 64 * (j))
#define XB_TOP      3328
#define XB_TOPGEN   3392
#define XCD_BAR_WORDS 3456
#define XB_SPIN_CAP (1u << 18)
__device__ __forceinline__ unsigned xb_ld(unsigned* p)              { return __hip_atomic_load(p, __ATOMIC_RELAXED, __HIP_MEMORY_SCOPE_AGENT); }
__device__ __forceinline__ unsigned xb_add(unsigned* p, unsigned v) { return __hip_atomic_fetch_add(p, v, __ATOMIC_RELAXED, __HIP_MEMORY_SCOPE_AGENT); }
__device__ __forceinline__ unsigned xb_xcc_id() { return (unsigned)__builtin_amdgcn_s_getreg((3 << 11) | 20) & 0xFu; }
#define XB_SPIN(cond, bar) do { unsigned _sp = 0; while (cond) { __builtin_amdgcn_s_sleep(1); \
    if ((++_sp & 255u) == 0u) { if (xb_ld(&(bar)[XB_TMO])) break; if (_sp > XB_SPIN_CAP) { atomicAdd(&(bar)[XB_TMO], 1u); break; } } } } while (0)
struct XcdBarrier { unsigned* bar; unsigned x; volatile LAS unsigned* st; };
__device__ __forceinline__ XcdBarrier xcd_barrier_post(unsigned* bar, volatile LAS unsigned* st) {
    XcdBarrier b; b.bar = bar; b.x = xb_xcc_id(); b.st = st;
    if (threadIdx.x == 0) (void)xb_add(&bar[XB_XCNT(b.x)], 1u);
    return b;
}
__device__ __forceinline__ void xcd_barrier_complete(unsigned* bar, unsigned x, unsigned& nloc, unsigned& nx) {
    const unsigned G = gridDim.x * gridDim.y * gridDim.z;
    unsigned sum, cnt, mine, sp = 0u;
    for (;;) {
        sum = 0u; cnt = 0u; mine = 0u;
#pragma unroll
        for (unsigned j = 0; j < 16; ++j) { const unsigned c = xb_ld(&bar[XB_XCNT(j)]); sum += c; cnt += (c > 0u) ? 1u : 0u; mine = (j == x) ? c : mine; }
        if (sum == G) break;
        __builtin_amdgcn_s_sleep(1);
        if ((++sp & 255u) == 0u) { if (xb_ld(&bar[XB_TMO])) break; if (sp > XB_SPIN_CAP) { atomicAdd(&bar[XB_TMO], 1u); break; } }
    }
    nloc = mine > 0u ? mine : 1u; nx = cnt > 0u ? cnt : 1u;
}
__device__ __forceinline__ void xcd_barrier(const XcdBarrier& b) {
    asm volatile("s_waitcnt vmcnt(0)" ::: "memory");
    __syncthreads();
    if (threadIdx.x == 0) {
        unsigned* bar = b.bar;
        __builtin_amdgcn_s_waitcnt(0);
        unsigned nloc = b.st[0], nx = b.st[1];
        if (nloc == 0u) { xcd_barrier_complete(bar, b.x, nloc, nx); b.st[0] = nloc; b.st[1] = nx; }
        const unsigned old = xb_add(&bar[XB_XSUB(b.x)], 1u);
        const unsigned gen = old / nloc;
        if (old + 1u == (gen + 1u) * nloc) {
            __builtin_amdgcn_fence(__ATOMIC_RELEASE, "agent");
            asm volatile("s_waitcnt vmcnt(0)" ::: "memory");
            const unsigned og = xb_add(&bar[XB_TOP], 1u);
            const unsigned tg = og / nx;
            if (og + 1u == (tg + 1u) * nx) xb_add(&bar[XB_TOPGEN], 1u);
            else XB_SPIN(xb_ld(&bar[XB_TOPGEN]) == tg, bar);
            __builtin_amdgcn_fence(__ATOMIC_ACQUIRE, "agent");
            xb_add(&bar[XB_XGEN(b.x)], 1u);
            asm volatile("s_waitcnt vmcnt(0)" ::: "memory");
        } else {
            XB_SPIN(xb_ld(&bar[XB_XGEN(b.x)]) == gen, bar);
            __builtin_amdgcn_fence(__ATOMIC_ACQUIRE, "agent");
            asm volatile("s_waitcnt vmcnt(0)" ::: "memory");
        }
    }
    __syncthreads();
}

__global__ void __launch_bounds__(512, 2) hybrid_fwd(Params P0) {
    extern __shared__ __attribute__((aligned(16))) unsigned char lds_raw[];
    LAS unsigned char* lds = (LAS unsigned char*)lds_raw;
    cg::grid_group grid = cg::this_grid();
    const int G = gridDim.x, bx = blockIdx.x, NGW = G * 8;
    XcdBarrier xbar; xbar.bar = nullptr; xbar.x = 0; xbar.st = nullptr;
    if (P0.ph_hi - P0.ph_lo > 1) {
        unsigned* bw = (unsigned*)(P0.ws + WS_CTL) + 4096;
        volatile LAS unsigned* st = (volatile LAS unsigned*)(lds + LDS_BYTES - 32);
        if (threadIdx.x == 0) { st[0] = 0u; st[1] = 0u; }
        __syncthreads();
        if (P0.ph_lo < 0) grid.sync();
        xbar = xcd_barrier_post(bw, st);
    }
    for (int ph = P0.ph_lo; ph < P0.ph_hi; ++ph) {
        const int L = ph / NPH_LAYER; int sub = ph % NPH_LAYER; int rep = 0; if (PROBE_SUB >= 0 && sub > PROBE_SUB) { rep = (sub == PROBE_SUB + 1); --sub; } if (ph == NPHASES - 1) sub = 99;
        const int tid = opaque_tid(), lane = tid & 63, wid = __builtin_amdgcn_readfirstlane(tid >> 6), gw = bx * 8 + wid;
        CP* pp = (CP*)__builtin_amdgcn_kernarg_segment_ptr(); asm volatile("" : "+s"(pp)); CP& P = *pp;
        unsigned* ctl = (unsigned*)(P.ws + WS_CTL); u64_t* RSS = (u64_t*)(P.ws + WS_RSS);
        bf16_t* Hin = (bf16_t*)P.out + (L == 0 ? (size_t)0 : (size_t)T * DM); bf16_t* Hout = (L == 0) ? (bf16_t*)P.out + (size_t)T * DM : (bf16_t*)(P.ws + WS_HB);
        if (sub == 0 && PHON(0)) {
            if (bx == 0 && tid == 0) {
                ctl[64 + 2 * L] = 0u; ctl[64 + 2 * L + 1] = 0u;
                float s1 = 0.f, s2 = 0.f;
                for (int i = 0; i < 64; ++i) { s1 += P.in[I_LQ1][L * 64 + i] * P.in[I_LK1][L * 64 + i]; s2 += P.in[I_LQ2][L * 64 + i] * P.in[I_LK2][L * 64 + i]; }
                const float lam_init = 0.8f - 0.6f * expf(-0.3f * (float)L);
                ((float*)ctl)[128 + L] = expf(s1) - expf(s2) + lam_init;
            }
            LAS float* scr = (LAS float*)(lds + wid * 16384);
            constexpr int I_IN = 32 * 176, I_OUT = 32 * 64, I_UP = 32 * 256, I_DN = 128 * 64, I_GT = 32 * 64, I_PL = 4 * 64, NIT = I_IN + I_OUT + I_UP + I_DN + I_GT + I_PL;
            for (int it = gw; it < NIT; it += NGW) { int q = it;
                if (q < I_IN) { transpose_item<true>(P.in[I_WIN] + (size_t)L * DM * IN_COLS, P.in[I_NMIXG] + L * DM, DM, IN_COLS, 176, (bf16_t*)(P.ws + WS_WIN), scr, q, lane); continue; } q -= I_IN;
                if (q < I_OUT) { transpose_item<false>(P.in[I_WOUT] + (size_t)L * DM * DM, nullptr, DM, DM, 64, (bf16_t*)(P.ws + WS_WOUT), scr, q, lane); continue; } q -= I_OUT;
                if (q < I_UP) { transpose_item<false>(P.in[I_WUP] + (size_t)L * DM * DFF, P.in[I_NMLPG] + L * DM, DM, DFF, 256, (bf16_t*)(P.ws + WS_WUP), scr, q, lane); continue; } q -= I_UP;
                if (q < I_DN) { transpose_item<false>(P.in[I_WDN] + (size_t)L * DFF * DM, nullptr, DFF, DM, 64, (bf16_t*)(P.ws + WS_WDN), scr, q, lane); continue; } q -= I_DN;
                if (q < I_GT) { transpose_item<false>(P.in[I_WG] + (size_t)L * DM * DM, P.in[I_NPLEG] + L * DM, DM, DM, 64, (bf16_t*)(P.ws + WS_WG), scr, q, lane); continue; } q -= I_GT;
                transpose_item<false>(P.in[I_WPLE] + (size_t)L * PLE * DM, nullptr, PLE, DM, 64, (bf16_t*)(P.ws + WS_WPLE), scr, q, lane);
            }
            if (L == 0) {
                { const int nth = G * 512, nit = (6 * T + nth - 1) / nth; for (int k = 0; k < nit; ++k) { const int i = k * nth + bx * 512 + tid; if (i < 6 * T) RSS[i] = 0ull; } }
                for (int m = gw; m < T; m += NGW) {
                    const float* src = (m < TP) ? P.in[I_XP] + (size_t)m * DM : P.in[I_XS] + (size_t)(m - TP) * DM;
                    prep_row(src, Hin + (size_t)m * DM, RSS + 6 * T + m, lane);
                }
            }
        } else if ((sub == 1 || sub == 5 || sub == 6 || sub == 7 || sub == 8 || sub == 9) && PHON(1)) {
            if (sub == 7) {
                bf16_t* PB = (bf16_t*)(P.ws + WS_PB);
                for (int m = gw; m < T; m += NGW) {
                    const float* pr = (m < TP) ? P.in[I_PP] + ((size_t)L * TP + m) * PLE : P.in[I_PS] + ((size_t)L * TS + (m - TP)) * PLE;
                    const f32x4 v = *((const f32x4*)pr + lane); u32x2 w; w.x = cvtpk(v.x, v.y); w.y = cvtpk(v.z, v.w); *((u32x2*)(PB + (size_t)m * PLE) + lane) = w; }
            }
            pg8::Gemm g; pg8::EpiAny E; E.O = nullptr; E.ldc = DM; E.Hs = Hin; E.dt = (float*)(P.ws + WS_DT); E.PE = (const bf16_t*)(P.ws + WS_PE); E.perm = true; g.M = T;
            E.HB = Hin; E.rin = RSS; E.rout = RSS;
            const bf16_t* HBp = Hin;
            if (sub == 1)      { g.A = HBp; g.Bt = (const bf16_t*)(P.ws + WS_WIN); g.N = PROJ_PITCH; g.K = DM; E.kind = 0; E.O = (bf16_t*)(P.ws + WS_PROJ); E.ldc = PROJ_PITCH; E.rin = RSS + (L == 0 ? 6 : 2) * T; }
            else if (sub == 5) { g.A = (const bf16_t*)(P.ws + WS_MIX); g.Bt = (const bf16_t*)(P.ws + WS_WOUT); g.N = DM; g.K = DM; E.kind = 1; E.rout = RSS + (3 * L + 0) * T; }
            else if (sub == 6) { g.A = HBp; g.Bt = (const bf16_t*)(P.ws + WS_WUP); g.N = DFF; g.K = DM; E.kind = 2; E.O = (bf16_t*)(P.ws + WS_HID); E.ldc = DFF; E.rin = RSS + (3 * L + 0) * T; }
            else if (sub == 7) { g.A = (const bf16_t*)(P.ws + WS_HID); g.Bt = (const bf16_t*)(P.ws + WS_WDN); g.N = DM; g.K = DFF; E.kind = 1; E.rout = RSS + (3 * L + 1) * T; }
            else if (sub == 8) { g.A = (const bf16_t*)(P.ws + WS_PB); g.Bt = (const bf16_t*)(P.ws + WS_WPLE); g.N = DM; g.K = PLE; E.kind = 3; E.O = (bf16_t*)(P.ws + WS_PE); E.ldc = DM; }
            else               { g.A = HBp; g.Bt = (const bf16_t*)(P.ws + WS_WG); g.N = DM; g.K = DM; E.kind = 4; E.rin = RSS + (3 * L + 1) * T; E.rout = RSS + (3 * L + 2) * T; E.HB = Hout; }
            pg8::StaticOrder S; S.init(T, g.N, G, bx);
            pg8::gemm_phase<pg8::EpiAny>(lds, g, S, E);
            asm volatile("s_waitcnt vmcnt(0)" ::: "memory");
        } else if (sub == 2 && PHON(2)) {
            for (int it = bx; it < (T / 32 + 2) / 3; it += G) xbc_conv_item(P, L, it);
            for (int it = bx; it < T / 32; it += G) conv_module_item(P, L, it, lds);
        } else if (sub == 3 && PHON(3)) {
            const float lam = __uint_as_float(__hip_atomic_load(ctl + 128 + L, __ATOMIC_RELAXED, __HIP_MEMORY_SCOPE_AGENT)); const float lam_init = 0.8f - 0.6f * expf(-0.3f * (float)L);
            LAS int* qslot = (LAS int*)(lds + LDS_BYTES - 16);
            for (;;) {
                if (tid == 0) *qslot = (int)atomicAdd(&ctl[64 + 2 * L + rep], 1u);
                __syncthreads();
                const int item = *qslot;
                __syncthreads();
                if (item >= 288 + 1920) break;
                if (item < 288) { int sq, rem; if (item < 192) { sq = 4 + item / 24; rem = item % 24; } else { sq = (item - 192) / 24; rem = (item - 192) % 24; }
                    if (PHON(12)) ssd_item(P, L, sq, rem % 12, rem / 12, lds);
                } else { int sq, hh, qt;
                    if (item < 288 + 1536) { const int j = item - 288; sq = 4 + j / 192; hh = (j % 192) / 32; qt = j % 32; }
                    else { const int j = item - 288 - 1536; sq = j / 96; hh = (j % 96) / 16; qt = j % 16; }
                    if (PHON(13)) attn_item(P, L, sq, hh, qt, lam, lam_init, lds); }
            }
        } else if (sub == 4 && PHON(4)) {
            const bf16_t* YF = (const bf16_t*)(P.ws + WS_YF); const bf16_t* YB = (const bf16_t*)(P.ws + WS_YB); const bf16_t* xbc = (const bf16_t*)(P.ws + WS_XBC);
            const bf16_t* proj = (const bf16_t*)(P.ws + WS_PROJ); bf16_t* mix = (bf16_t*)(P.ws + WS_MIX);
            for (int m2 = gw; m2 < T / 2; m2 += NGW) { const int m = 2 * m2;
                float y[24]; float ss0 = 0.f, ss1 = 0.f;
#pragma unroll
                for (int j = 0; j < 3; ++j) { const int f = (j * 64 + lane) * 8, rw = f >= SSD_W ? 1 : 0, c0 = f - rw * SSD_W; const size_t row = (size_t)(m + rw);
                    const u32x4 a = *(const u32x4*)(YF + row * SSD_W + c0), b = *(const u32x4*)(YB + row * SSD_W + c0), x = *(const u32x4*)(xbc + row * XBC_W + c0), z = *(const u32x4*)(proj + row * PROJ_PITCH + ZOFF + c0);
                    const float dsk = P.in[I_SSDD][L * 12 + c0 / 64];
                    float fa[8], fb[8], fx[8], fz[8]; unpack8(a, fa); unpack8(b, fb); unpack8(x, fx); unpack8(z, fz); float sq = 0.f;
#pragma unroll
                    for (int k = 0; k < 8; ++k) { const float v = (fa[k] + fb[k] + dsk * fx[k]) * siluf_(fz[k]); y[j * 8 + k] = v; sq += v * v; }
                    if (rw) ss1 += sq; else ss0 += sq; }
                const float r0 = rsqrtf(wave_sum(ss0) * (1.f / SSD_W) + EPS), r1 = rsqrtf(wave_sum(ss1) * (1.f / SSD_W) + EPS);
#pragma unroll
                for (int j = 0; j < 3; ++j) { const int f = (j * 64 + lane) * 8, rw = f >= SSD_W ? 1 : 0, c0 = f - rw * SSD_W; const float rstd = rw ? r1 : r0;
                    const f32x4 g0 = *(const f32x4*)(P.in[I_SSDNG] + L * SSD_W + c0), g1 = *(const f32x4*)(P.in[I_SSDNG] + L * SSD_W + c0 + 4);
                    u32x4 w; w.x = cvtpk(y[j * 8] * rstd * g0.x, y[j * 8 + 1] * rstd * g0.y); w.y = cvtpk(y[j * 8 + 2] * rstd * g0.z, y[j * 8 + 3] * rstd * g0.w);
                    w.z = cvtpk(y[j * 8 + 4] * rstd * g1.x, y[j * 8 + 5] * rstd * g1.y); w.w = cvtpk(y[j * 8 + 6] * rstd * g1.z, y[j * 8 + 7] * rstd * g1.w);
                    *(u32x4*)(mix + (size_t)(m + rw) * DM + 512 + c0) = w; }
            }
        } else if (sub == 99 && PHON(11)) {
            for (int m = gw; m < T; m += NGW) final_row((const bf16_t*)(P.ws + WS_HB) + (size_t)m * DM, P.out + (size_t)m * DM, P.in[I_FNG], RSS[5 * T + m], lane);
        }
        if (ph + 1 < P0.ph_hi && sub != 8) xcd_barrier(xbar);
    }
}

extern "C" void kernel_launch(void* const* d_in, const int* in_sizes, int n_in, void* d_out, int out_size, void* d_ws, size_t ws_size, hipStream_t stream) {
    static int grid = 0;
    if (grid == 0) {
        if (n_in != 30 || out_size != T * DM || ws_size < WS_END) { fprintf(stderr, "kernel_launch: unexpected shapes (n_in %d out %d ws %zu)\n", n_in, out_size, ws_size); grid = -1; return; }
        int dev = 0, cus = 0, per_cu = 0;
        hipGetDevice(&dev); hipDeviceGetAttribute(&cus, hipDeviceAttributeMultiprocessorCount, dev);
        if (hipFuncSetAttribute((const void*)hybrid_fwd, hipFuncAttributeMaxDynamicSharedMemorySize, LDS_BYTES) != hipSuccess) { fprintf(stderr, "kernel_launch: hipFuncSetAttribute failed\n"); grid = -1; return; }
        hipOccupancyMaxActiveBlocksPerMultiprocessor(&per_cu, (const void*)hybrid_fwd, 512, LDS_BYTES);
        (void)hipGetLastError();
        if (per_cu < 1) fprintf(stderr, "kernel_launch: occupancy query says %d blocks per CU\n", per_cu);
        grid = cus > 0 ? cus : 256;
    }
    if (grid < 0) return;
    Params p{};
    for (int i = 0; i < 30; ++i) p.in[i] = (const float*)d_in[i];
    p.out = (float*)d_out; p.ws = (unsigned char*)d_ws;
#if MK_MULTI
    for (int ph = 0; ph < NPHASES; ++ph) { p.ph_lo = ph; p.ph_hi = ph + 1; hipLaunchKernelGGL(hybrid_fwd, dim3(grid), dim3(512), LDS_BYTES, stream, p); }
#else
    p.ph_lo = 0; p.ph_hi = NPHASES;
    (void)hipMemsetAsync((unsigned char*)d_ws + WS_CTL + 4096 * 4, 0, XCD_BAR_WORDS * 4, stream);
    void* args[] = {&p};
    hipError_t e = hipLaunchCooperativeKernel((const void*)hybrid_fwd, dim3(grid), dim3(512), args, LDS_BYTES, stream);
    if (e != hipSuccess) fprintf(stderr, "kernel_launch: cooperative launch failed: %s (grid %d)\n", hipGetErrorString(e), grid);
#endif
}
```
